# Optimizing an MI355X kernel written in HIP

```python
import math
import jax, jax.numpy as jnp
from jax import lax
import numpy as np

D_MODEL = 1024
BATCH = 4
SEQ = 8192
DEPTH = 1

N_HEADS = 8
HEAD_DIM = D_MODEL // N_HEADS
ATTN_WIDTH = N_HEADS * HEAD_DIM
MOBA_BLOCK = 256
MOBA_TOPK = 3
Q_CHUNK = 32
ROPE_THETA = 10000.0
SSM_WIDTH = D_MODEL // 2
SSM_GROUP = 16
SSM_GROUPS = SSM_WIDTH // SSM_GROUP
SSM_STATE = 64
DT_MIN = 1e-3
DT_MAX = 1e-1
N_BRANCHES = 2
D_FF = 4 * D_MODEL
RMS_EPS = 1e-6
NEG_BIG = -1e30
IN_WIDTH = 3 * ATTN_WIDTH + SSM_WIDTH + N_BRANCHES * D_MODEL

kernel_name = "hybrid_moba_s5_gated_block"


def rms_norm(x, g):
    xf = x.astype(jnp.float32)
    y = xf * lax.rsqrt(jnp.mean(xf * xf, axis=-1, keepdims=True) + RMS_EPS)
    return (y * g.astype(jnp.float32)).astype(x.dtype)


def rotary(x, pos):
    half = HEAD_DIM // 2
    inv_freq = ROPE_THETA ** (-jnp.arange(half, dtype=jnp.float32) / half)
    ang = pos.astype(jnp.float32)[:, None] * inv_freq[None, :]
    cos = jnp.cos(ang)[None, :, None, :]
    sin = jnp.sin(ang)[None, :, None, :]
    xf = x.astype(jnp.float32)
    x1, x2 = xf[..., :half], xf[..., half:]
    out = jnp.concatenate([x1 * cos - x2 * sin, x2 * cos + x1 * sin], axis=-1)
    return out.astype(x.dtype)


def moba_attention(q, k, v):
    b, l, h, d = q.shape
    lp = -(-l // MOBA_BLOCK) * MOBA_BLOCK
    nb = lp // MOBA_BLOCK
    pad = ((0, 0), (0, lp - l), (0, 0), (0, 0))
    q, k, v = [jnp.pad(t, pad).transpose(0, 2, 1, 3) for t in (q, k, v)]
    kb = k.reshape(b, h, nb, MOBA_BLOCK, d)
    vb = v.reshape(b, h, nb, MOBA_BLOCK, d)
    k_mean = jnp.mean(kb.astype(jnp.float32), axis=3)
    gate = jnp.einsum('bhqd,bhnd->bhqn', q.astype(jnp.float32), k_mean)
    pos = jnp.arange(lp)
    q_blk = pos // MOBA_BLOCK
    past = jnp.arange(nb)[None, :] < q_blk[:, None]
    gate = jnp.where(past, gate, NEG_BIG)
    topk = min(MOBA_TOPK, nb)
    _, sel = lax.top_k(gate, topk)
    sel_valid = sel < q_blk[:, None]
    own = jnp.broadcast_to(q_blk[:, None].astype(sel.dtype), (b, h, lp, 1))
    idx = jnp.concatenate([sel, own], axis=-1)
    valid = jnp.concatenate([sel_valid, jnp.ones((b, h, lp, 1), dtype=bool)], axis=-1)

    nc = lp // Q_CHUNK

    def to_chunks(t):
        return jnp.moveaxis(t.reshape((b, h, nc, Q_CHUNK) + t.shape[3:]), 2, 0)

    bi = jnp.arange(b)[:, None, None, None]
    hi = jnp.arange(h)[None, :, None, None]
    key_off = jnp.arange(MOBA_BLOCK)
    scale = HEAD_DIM ** -0.5

    def attend(args):
        qc, ic, vc, pc = args
        kg = kb[bi, hi, ic]
        vg = vb[bi, hi, ic]
        s = jnp.einsum('bhqd,bhqskd->bhqsk', qc, kg,
                       preferred_element_type=jnp.float32) * scale
        kpos = ic[..., None] * MOBA_BLOCK + key_off
        mask = vc[..., None] & (kpos <= pc[None, None, :, None, None])
        s = jnp.where(mask, s, NEG_BIG)
        p = jax.nn.softmax(s.reshape(b, h, Q_CHUNK, -1), axis=-1).reshape(s.shape)
        return jnp.einsum('bhqsk,bhqskd->bhqd', p.astype(vg.dtype), vg)

    out = lax.map(attend, (to_chunks(q), to_chunks(idx), to_chunks(valid),
                           pos.reshape(nc, Q_CHUNK)))
    out = jnp.moveaxis(out, 0, 2).reshape(b, h, lp, d)[:, :, :l]
    return out.transpose(0, 2, 1, 3).reshape(b, l, h * d)


def s5_branch(u, lam_re, lam_im, log_step, b_re, b_im, c_re, c_im, d_skip, w_glu):
    b, l, _ = u.shape
    f32 = jnp.float32
    uf = u.astype(f32).reshape(b, l, SSM_GROUPS, SSM_GROUP)
    step = jnp.exp(log_step.astype(f32))[:, None]
    lr, li = lam_re.astype(f32), lam_im.astype(f32)
    mag = jnp.exp(lr * step)
    ar = mag * jnp.cos(li * step)
    ai = mag * jnp.sin(li * step)
    den = lr * lr + li * li
    nr, ni = ar - 1.0, ai
    cr = (nr * lr + ni * li) / den
    ci = (ni * lr - nr * li) / den
    bu_r = jnp.einsum('blgc,gnc->blgn', uf, b_re.astype(f32))
    bu_i = jnp.einsum('blgc,gnc->blgn', uf, b_im.astype(f32))
    xr0 = cr * bu_r - ci * bu_i
    xi0 = cr * bu_i + ci * bu_r
    a_r = jnp.broadcast_to(ar[None, None], (1, l, SSM_GROUPS, SSM_STATE))
    a_i = jnp.broadcast_to(ai[None, None], (1, l, SSM_GROUPS, SSM_STATE))

    def combine(e1, e2):
        a1r, a1i, b1r, b1i = e1
        a2r, a2i, b2r, b2i = e2
        return (a2r * a1r - a2i * a1i,
                a2r * a1i + a2i * a1r,
                a2r * b1r - a2i * b1i + b2r,
                a2r * b1i + a2i * b1r + b2i)

    _, _, sr, si = lax.associative_scan(combine, (a_r, a_i, xr0, xi0), axis=1)
    y = (jnp.einsum('blgn,gcn->blgc', sr, c_re.astype(f32))
         - jnp.einsum('blgn,gcn->blgc', si, c_im.astype(f32))
         + d_skip.astype(f32) * uf)
    y = jax.nn.gelu(y.reshape(b, l, SSM_WIDTH)).astype(u.dtype)
    hgl = y @ w_glu
    val, gt = jnp.split(hgl, 2, axis=-1)
    return val * jax.nn.sigmoid(gt)


def setup_inputs(seed: int = 0) -> dict:
    key = jax.random.key(seed)
    ks = jax.random.split(key, 20)
    f32 = jnp.float32
    nrm = lambda k, s, sc: jax.random.normal(k, s, f32) * sc
    x = jax.random.normal(ks[0], (BATCH, SEQ, D_MODEL), f32)
    norm_mix_g = 1.0 + nrm(ks[1], (DEPTH, D_MODEL), 0.02)
    w_in = nrm(ks[2], (DEPTH, D_MODEL, IN_WIDTH), D_MODEL ** -0.5)
    n_idx = jnp.arange(SSM_STATE, dtype=f32)
    lam_re = -0.5 + nrm(ks[3], (DEPTH, SSM_GROUPS, SSM_STATE), 0.01)
    lam_im = jnp.broadcast_to(math.pi * n_idx, (DEPTH, SSM_GROUPS, SSM_STATE)) \
        + nrm(ks[4], (DEPTH, SSM_GROUPS, SSM_STATE), 0.01)
    log_step = jax.random.uniform(ks[5], (DEPTH, SSM_GROUPS), f32,
                                  math.log(DT_MIN), math.log(DT_MAX))
    b_sc = (2.0 * SSM_GROUP) ** -0.5
    b_re = nrm(ks[6], (DEPTH, SSM_GROUPS, SSM_STATE, SSM_GROUP), b_sc)
    b_im = nrm(ks[7], (DEPTH, SSM_GROUPS, SSM_STATE, SSM_GROUP), b_sc)
    c_sc = (2.0 * SSM_STATE) ** -0.5
    c_re = nrm(ks[8], (DEPTH, SSM_GROUPS, SSM_GROUP, SSM_STATE), c_sc)
    c_im = nrm(ks[9], (DEPTH, SSM_GROUPS, SSM_GROUP, SSM_STATE), c_sc)
    d_skip = nrm(ks[10], (DEPTH, SSM_GROUPS, SSM_GROUP), 1.0)
    w_glu = nrm(ks[11], (DEPTH, SSM_WIDTH, 2 * D_MODEL), SSM_WIDTH ** -0.5)
    w_out = nrm(ks[12], (DEPTH, D_MODEL, D_MODEL), D_MODEL ** -0.5)
    norm_mlp_g = 1.0 + nrm(ks[13], (DEPTH, D_MODEL), 0.02)
    w_up = nrm(ks[14], (DEPTH, D_MODEL, D_FF), D_MODEL ** -0.5)
    w_down = nrm(ks[15], (DEPTH, D_FF, D_MODEL), D_FF ** -0.5)
    norm_final_g = 1.0 + nrm(ks[16], (D_MODEL,), 0.02)
    return {"x": x, "norm_mix_g": norm_mix_g, "w_in": w_in, "lam_re": lam_re,
            "lam_im": lam_im, "log_step": log_step, "b_re": b_re, "b_im": b_im,
            "c_re": c_re, "c_im": c_im, "d_skip": d_skip, "w_glu": w_glu,
            "w_out": w_out, "norm_mlp_g": norm_mlp_g, "w_up": w_up,
            "w_down": w_down, "norm_final_g": norm_final_g}


def reference(x, norm_mix_g, w_in, lam_re, lam_im, log_step, b_re, b_im, c_re, c_im,
              d_skip, w_glu, w_out, norm_mlp_g, w_up, w_down, norm_final_g):
    b, l, _ = x.shape
    pos = jnp.arange(l)
    splits = [ATTN_WIDTH, 2 * ATTN_WIDTH, 3 * ATTN_WIDTH, 3 * ATTN_WIDTH + SSM_WIDTH]
    for i in range(DEPTH):
        h = rms_norm(x, norm_mix_g[i])
        proj = h @ w_in[i]
        q, k, v, u, g = jnp.split(proj, splits, axis=-1)
        q = rotary(q.reshape(b, l, N_HEADS, HEAD_DIM), pos)
        k = rotary(k.reshape(b, l, N_HEADS, HEAD_DIM), pos)
        v = v.reshape(b, l, N_HEADS, HEAD_DIM)
        o_a = moba_attention(q, k, v)
        o_b = s5_branch(u, lam_re[i], lam_im[i], log_step[i], b_re[i], b_im[i],
                        c_re[i], c_im[i], d_skip[i], w_glu[i])
        g_a, g_b = jnp.split(g, 2, axis=-1)
        mixed = jax.nn.sigmoid(g_a) * o_a + jax.nn.sigmoid(g_b) * o_b
        x = x + mixed @ w_out[i]
        h = rms_norm(x, norm_mlp_g[i])
        x = x + jnp.square(jax.nn.relu(h @ w_up[i])) @ w_down[i]
    return rms_norm(x, norm_final_g)
```

```cpp
#include <hip/hip_runtime.h>
#include <hip/hip_cooperative_groups.h>
#include <cstdio>
#include <cstdint>
namespace cg = cooperative_groups;

namespace pg8 {
#define PG8_LAS __attribute__((address_space(3)))
typedef unsigned short bf16_t;
typedef short bf16x8 __attribute__((ext_vector_type(8)));
typedef float f32x4 __attribute__((ext_vector_type(4)));
typedef unsigned u32x4 __attribute__((ext_vector_type(4)));
typedef unsigned u32x2 __attribute__((ext_vector_type(2)));
constexpr int BM = 256, BK = 64, HALF = 128, HTB = HALF * BK * 2, STAGE_BYTES = 8 * HTB, NXCD = 8, WGM = 4;

__host__ __device__ __forceinline__ int lds_byte(int r, int c) { const int st = (r >> 4) * 2 + (c >> 5), rr = r & 15, cc = c & 31, ob = rr * 64 + cc * 2; return st * 1024 + (ob ^ (((ob >> 9) & 1) << 5)); }
__host__ __device__ __forceinline__ void stage_rc(int b, int& R, int& C) { const int st = b / 1024, sb = b % 1024, swz = sb ^ (((sb >> 9) & 1) << 5); R = (st >> 1) * 16 + swz / 64; C = (st & 1) * 32 + (swz % 64) / 2; }
__host__ __device__ __forceinline__ int perm32(int rho) { const int n = rho >> 4, i = rho & 15; return 8 * (i >> 2) + 4 * n + (i & 3); }

struct Unit { int pm, pn; };
struct Gemm { const bf16_t* A; const bf16_t* Bt; int M, N, K; };

struct StaticOrder {
    int nM, nN, nwg, G, c;
    __host__ __device__ void init(int M, int N, int G_, int c_) { nM = M / BM; nN = N / BM; nwg = nM * nN; G = G_; c = c_; }
    __host__ __device__ bool next(int i, Unit& u) const {
        const long L = (long)i * G + c; if (L >= nwg) return false;
        int wgid = (int)L; { const int q = nwg / NXCD, r = nwg % NXCD, xcd = wgid % NXCD, off = wgid / NXCD; wgid = (xcd < r ? xcd * (q + 1) : r * (q + 1) + (xcd - r) * q) + off; }
        const int nig = WGM * nN, gid = wgid / nig, fm = gid * WGM, gsz = (nM - fm) < WGM ? (nM - fm) : WGM;
        u.pm = fm + ((wgid % nig) % gsz); u.pn = (wgid % nig) / gsz; return true;
    }
    __device__ __forceinline__ void a_ready(const Unit&) const {}
    __device__ __forceinline__ void done(const Unit&) const {}
};

typedef float f32x2 __attribute__((ext_vector_type(2)));
typedef __bf16 bf16x2_t __attribute__((ext_vector_type(2)));
__device__ __forceinline__ unsigned cvt_pk_bf16(float lo, float hi) { f32x2 v = {lo, hi}; bf16x2_t b = __builtin_convertvector(v, bf16x2_t); return __builtin_bit_cast(unsigned, b); }

template <class Epi, class Sched, bool ALIGN_EPI = false, bool SP2 = false>
__device__ __forceinline__ void gemm_phase(PG8_LAS unsigned char* lds, const Gemm g, const Sched& S, const Epi& E) {
    int tid = threadIdx.x; asm volatile("" : "+v"(tid));
    const int wid = __builtin_amdgcn_readfirstlane(tid >> 6), lane = tid & 63, wr = wid >> 2, wc = wid & 3, fr = lane & 15, fq = lane >> 4;
    const int K = g.K, nt = K / BK;
    unsigned voffA[2], voffB[2];
#pragma unroll
    for (int i = 0; i < 2; ++i) { int R, C; stage_rc(tid * 16 + i * 8192, R, C); const int Rb = Epi::PERM ? ((R & ~31) + perm32(R & 31)) : R;
        voffA[i] = (unsigned)(R * K + C) * 2u; voffB[i] = (unsigned)(Rb * K + C) * 2u; }
    const size_t kstep = (size_t)(BK * 2);
    const size_t hstep = (size_t)HALF * K * 2;
    const size_t tstep = 2 * hstep;
    const unsigned ldsw = (unsigned)wid * 1024u;
    const int aoff = lds_byte(wr * 64 + fr, fq * 8), boff = lds_byte(wc * 32 + fr, fq * 8);
#define PG8_SA(b, h) (((b) * 2 + (h)) * HTB)
#define PG8_SB(b, h) ((4 + (b) * 2 + (h)) * HTB)
#define PG8_STAGE(bufoff, gbase, voff) do { _Pragma("unroll") for (int _i = 0; _i < 2; ++_i) \
        __builtin_amdgcn_global_load_lds((const unsigned*)((const char*)(gbase) + (voff)[_i]), (PG8_LAS unsigned*)(lds + (bufoff) + ldsw + _i * 8192), 16, 0, 0); } while (0)
#define PG8_LDA(dst, b, h) do { _Pragma("unroll") for (int m = 0; m < 4; ++m) _Pragma("unroll") for (int k = 0; k < 2; ++k) dst[m][k] = *(const PG8_LAS bf16x8*)(lds + PG8_SA(b, h) + aoff + m * 2048 + k * 1024); } while (0)
#define PG8_LDB(dst, b, h) do { _Pragma("unroll") for (int n = 0; n < 2; ++n) _Pragma("unroll") for (int k = 0; k < 2; ++k) dst[n][k] = *(const PG8_LAS bf16x8*)(lds + PG8_SB(b, h) + boff + n * 2048 + k * 1024); } while (0)
#define PG8_MMA(ai, bj, At, Bt) do { __builtin_amdgcn_s_setprio(1); _Pragma("unroll") for (int m = 0; m < 4; ++m) _Pragma("unroll") for (int n = 0; n < 2; ++n) _Pragma("unroll") for (int k = 0; k < 2; ++k) \
        acc[ai][bj][m][n] = __builtin_amdgcn_mfma_f32_16x16x32_bf16(Bt[n][k], At[m][k], acc[ai][bj][m][n], 0, 0, 0); __builtin_amdgcn_s_setprio(0); } while (0)
#define PG8_WAIT_V(n) asm volatile("s_waitcnt vmcnt(" #n ")" ::: "memory")
#define PG8_WAIT_L(n) asm volatile("s_waitcnt lgkmcnt(" #n ")" ::: "memory")
#define PG8_BAR __builtin_amdgcn_s_barrier()
#define PG8_SCHED __builtin_amdgcn_sched_barrier(0)
    Unit cur, nxt; int ui = 0;
    if (!S.next(0, cur)) return;
    f32x4 acc[2][2][4][2];
#pragma unroll
    for (int a = 0; a < 2; ++a)
#pragma unroll
        for (int b = 0; b < 2; ++b)
#pragma unroll
            for (int m = 0; m < 4; ++m)
#pragma unroll
                for (int n = 0; n < 2; ++n) acc[a][b][m][n] = (f32x4){0.f, 0.f, 0.f, 0.f};
    bf16x8 At[4][2], B0[2][2], B1[2][2];
    const char* cA = (const char*)g.A + (size_t)cur.pm * tstep; const char* cB = (const char*)g.Bt + (size_t)cur.pn * tstep;
    S.a_ready(cur);
    if constexpr (SP2) {
        PG8_STAGE(PG8_SB(0, 0), cB, voffB); PG8_STAGE(PG8_SB(0, 1), cB + hstep, voffB); PG8_STAGE(PG8_SA(0, 0), cA, voffA); PG8_STAGE(PG8_SA(0, 1), cA + hstep, voffA);
        if (wr == 1) PG8_BAR;
        PG8_WAIT_V(2); PG8_BAR;
        PG8_STAGE(PG8_SB(1, 0), cB + kstep, voffB); PG8_STAGE(PG8_SA(1, 0), cA + kstep, voffA); PG8_STAGE(PG8_SB(1, 1), cB + hstep + kstep, voffB);
        PG8_WAIT_V(6); PG8_BAR;
    } else {
        PG8_STAGE(PG8_SB(0, 0), cB, voffB); PG8_STAGE(PG8_SA(0, 0), cA, voffA); PG8_STAGE(PG8_SB(0, 1), cB + hstep, voffB); PG8_STAGE(PG8_SA(0, 1), cA + hstep, voffA);
        if (wr == 1) PG8_BAR;
        PG8_WAIT_V(4); PG8_BAR;
        PG8_STAGE(PG8_SB(1, 0), cB + kstep, voffB); PG8_STAGE(PG8_SA(1, 0), cA + kstep, voffA); PG8_STAGE(PG8_SB(1, 1), cB + hstep + kstep, voffB);
        PG8_WAIT_V(6); PG8_BAR;
    }
    for (;;) {
        const bool has_next = S.next(ui + 1, nxt);
        const char* nA = has_next ? (const char*)g.A + (size_t)nxt.pm * tstep : cA; const char* nB = has_next ? (const char*)g.Bt + (size_t)nxt.pn * tstep : cB;
        for (int t = 0; t < nt; t += 2) {
            const bool last = (t == nt - 2);
            const char* a1 = cA + (size_t)(t + 1) * kstep;
            const char* a2 = last ? nA : cA + (size_t)(t + 2) * kstep; const char* b2 = last ? nB : cB + (size_t)(t + 2) * kstep;
            const char* a3 = a2 + kstep; const char* b3 = b2 + kstep;
            if (last && has_next) S.a_ready(nxt);
            if constexpr (SP2) {
            PG8_LDB(B0, 0, 0); PG8_LDB(B1, 0, 1); PG8_SCHED; PG8_LDA(At, 0, 0); PG8_STAGE(PG8_SA(1, 1), a1 + hstep, voffA);
            PG8_WAIT_V(8); PG8_WAIT_L(0); PG8_BAR; PG8_MMA(0, 0, At, B0); PG8_MMA(0, 1, At, B1); PG8_BAR; PG8_SCHED;
            PG8_LDA(At, 0, 1); PG8_STAGE(PG8_SB(0, 0), b2, voffB); PG8_STAGE(PG8_SB(0, 1), b2 + hstep, voffB); PG8_STAGE(PG8_SA(0, 0), a2, voffA);
            PG8_WAIT_V(8); PG8_WAIT_L(0); PG8_BAR; PG8_MMA(1, 0, At, B0); PG8_MMA(1, 1, At, B1); PG8_BAR; PG8_SCHED;
            PG8_LDB(B0, 1, 0); PG8_LDB(B1, 1, 1); PG8_SCHED; PG8_LDA(At, 1, 0); PG8_STAGE(PG8_SA(0, 1), a2 + hstep, voffA);
            PG8_WAIT_V(8); PG8_WAIT_L(0); PG8_BAR; PG8_MMA(0, 0, At, B0); PG8_MMA(0, 1, At, B1); PG8_BAR; PG8_SCHED;
            PG8_LDA(At, 1, 1); PG8_STAGE(PG8_SB(1, 0), b3, voffB); PG8_STAGE(PG8_SB(1, 1), b3 + hstep, voffB); PG8_STAGE(PG8_SA(1, 0), a3, voffA);
            PG8_WAIT_V(8); PG8_WAIT_L(0); PG8_BAR; PG8_MMA(1, 0, At, B0); PG8_MMA(1, 1, At, B1); PG8_BAR; PG8_SCHED;
            } else {
            PG8_LDB(B0, 0, 0); PG8_SCHED; PG8_LDA(At, 0, 0); PG8_STAGE(PG8_SA(1, 1), a1 + hstep, voffA);
            PG8_WAIT_L(8); PG8_BAR; PG8_WAIT_L(0); PG8_MMA(0, 0, At, B0); PG8_BAR; PG8_SCHED;
            PG8_LDB(B1, 0, 1); PG8_STAGE(PG8_SB(0, 0), b2, voffB);
            PG8_BAR; PG8_WAIT_L(0); PG8_MMA(0, 1, At, B1); PG8_BAR;
            PG8_LDA(At, 0, 1); PG8_STAGE(PG8_SA(0, 0), a2, voffA);
            PG8_BAR; PG8_WAIT_L(0); PG8_MMA(1, 0, At, B0); PG8_BAR; PG8_SCHED;
            PG8_STAGE(PG8_SB(0, 1), b2 + hstep, voffB);
            PG8_WAIT_V(6); PG8_BAR; PG8_MMA(1, 1, At, B1); PG8_BAR;
            PG8_LDB(B0, 1, 0); PG8_SCHED; PG8_LDA(At, 1, 0); PG8_STAGE(PG8_SA(0, 1), a2 + hstep, voffA);
            PG8_WAIT_L(8); PG8_BAR; PG8_WAIT_L(0); PG8_MMA(0, 0, At, B0); PG8_BAR; PG8_SCHED;
            PG8_LDB(B1, 1, 1); PG8_STAGE(PG8_SB(1, 0), b3, voffB);
            PG8_BAR; PG8_WAIT_L(0); PG8_MMA(0, 1, At, B1); PG8_BAR;
            PG8_LDA(At, 1, 1); PG8_STAGE(PG8_SA(1, 0), a3, voffA);
            PG8_BAR; PG8_WAIT_L(0); PG8_MMA(1, 0, At, B0); PG8_BAR; PG8_SCHED;
            PG8_STAGE(PG8_SB(1, 1), b3 + hstep, voffB);
            PG8_WAIT_V(6); PG8_BAR; PG8_MMA(1, 1, At, B1); PG8_BAR;
            }
        }
        if constexpr (ALIGN_EPI) { if (wr == 0) PG8_BAR; }
        E(acc, cur, wr, wc, fr, fq); S.done(cur);
        if (!has_next) break;
#pragma unroll
        for (int a = 0; a < 2; ++a)
#pragma unroll
            for (int b = 0; b < 2; ++b)
#pragma unroll
                for (int m = 0; m < 4; ++m)
#pragma unroll
                    for (int n = 0; n < 2; ++n) acc[a][b][m][n] = (f32x4){0.f, 0.f, 0.f, 0.f};
        cur = nxt; cA = nA; cB = nB; ++ui;
        if constexpr (ALIGN_EPI) { if (wr == 1) PG8_BAR; }
    }
    PG8_WAIT_V(0);
    if constexpr (!ALIGN_EPI) { if (wr == 0) PG8_BAR; }
    PG8_BAR;
#undef PG8_SA
#undef PG8_SB
#undef PG8_STAGE
#undef PG8_LDA
#undef PG8_LDB
#undef PG8_MMA
#undef PG8_WAIT_V
#undef PG8_WAIT_L
#undef PG8_BAR
#undef PG8_SCHED
}
}

using pg8::bf16_t; using pg8::bf16x8; using pg8::f32x4; using pg8::u32x4; using pg8::u32x2; using pg8::cvt_pk_bf16; using pg8::Unit;
typedef float f32x16 __attribute__((ext_vector_type(16)));
typedef unsigned long long u64;
typedef float f32x2 __attribute__((ext_vector_type(2)));

constexpr int BATCH = 4, SEQ = 8192, DM = 1024, NH = 8, HD = 128, FF = 4096, M = BATCH * SEQ;
constexpr int SSMW = 512, NG = 32, GC = 16, NS = 64, NIN = 5632, NBLK = 32, BLK = 256;
constexpr float RMS_EPS = 1e-6f;
constexpr float QSCALE = 0.08838834764831845f * 1.4426950408889634f;
constexpr int NSEG = SEQ / 64;

constexpr size_t MiB = 1u << 20;
constexpr size_t WS_CTL = 0;
constexpr size_t WS_WIN = 1 * MiB, WS_WGLU = 12 * MiB, WS_WOUT = 14 * MiB, WS_WUP = 16 * MiB, WS_WDN = 24 * MiB;
constexpr size_t WS_ROPE = 33 * MiB;
constexpr size_t WS_KM = 37 * MiB;
constexpr size_t WS_SEL = 38 * MiB;
constexpr size_t WS_SS = 39 * MiB;
constexpr size_t WS_AGG = 41 * MiB;
constexpr size_t WS_ML = 49 * MiB;
constexpr size_t WS_Q = 64 * MiB;
constexpr size_t WS_K = 128 * MiB;
constexpr size_t WS_VT = 192 * MiB;
constexpr size_t WS_U = 256 * MiB;
constexpr size_t WS_Y = 288 * MiB;
constexpr size_t WS_PO = 320 * MiB;
constexpr size_t WS_XN = 320 * MiB;
constexpr size_t WS_H = 256 * MiB;
constexpr size_t WS_END = 512 * MiB;
constexpr int LDS_BYTES = 155648;

__device__ __forceinline__ float sigmoidf_(float x) { return __builtin_amdgcn_rcpf(1.0f + __builtin_amdgcn_exp2f(-1.4426950408889634f * x)); }
__device__ __forceinline__ float bf2f(unsigned short b) { return __uint_as_float((unsigned)b << 16); }
__device__ __forceinline__ float wave_sum(float v) {
#pragma unroll
    for (int o = 1; o < 64; o <<= 1) v += __shfl_xor(v, o);
    return v;
}
__device__ __forceinline__ int crow(int r, int hi) { return (r & 3) + 8 * (r >> 2) + 4 * hi; }

struct Params {
    const float* in[17]; float* out; unsigned char* ws;
};

struct EpiProj {
    static constexpr bool PERM = true, AFTER_DRAIN = false;
    bf16_t *Q, *K, *VT, *U, *GAB; float* KM; const float* rope;
    __device__ __forceinline__ void operator()(const f32x4 (&acc)[2][2][4][2], const Unit& u, int wr, int wc, int fr, int fq) const {
        const int pn = u.pn; const int rbase = u.pm * 256 + wr * 64 + fr;
#ifndef NO_QK
        if (pn < 8) {
            const bool isq = pn < 4; bf16_t* dst = isq ? Q : K; const int hcol = (pn & 3) * 256;
            f32x4 ks[2][2];
#pragma unroll
            for (int a = 0; a < 2; ++a)
#pragma unroll
                for (int b = 0; b < 2; ++b) ks[a][b] = (f32x4){0.f, 0.f, 0.f, 0.f};
#pragma unroll
            for (int ai = 0; ai < 2; ++ai)
#pragma unroll
                for (int m = 0; m < 4; ++m) {
                    const int row = rbase + ai * 128 + m * 16; const int t = row & (SEQ - 1);
                    const f32x4 cs = *(const f32x4*)(rope + (size_t)t * 128 + 16 * wc + 4 * fq);
                    const f32x4 sn = *(const f32x4*)(rope + (size_t)t * 128 + 64 + 16 * wc + 4 * fq);
#pragma unroll
                    for (int bj = 0; bj < 2; ++bj) {
                        const f32x4 x1 = acc[ai][bj][m][0], x2 = acc[ai][bj][m][1];
                        f32x4 o1 = x1 * cs - x2 * sn, o2 = x2 * cs + x1 * sn;
                        if (isq) { o1 = o1 * QSCALE; o2 = o2 * QSCALE; } else { ks[bj][0] += o1; ks[bj][1] += o2; }
                        u32x4 w; w.x = cvt_pk_bf16(o1[0], o1[1]); w.y = cvt_pk_bf16(o1[2], o1[3]); w.z = cvt_pk_bf16(o2[0], o2[1]); w.w = cvt_pk_bf16(o2[2], o2[3]);
                        *(u32x4*)(dst + (size_t)row * DM + hcol + bj * 128 + wc * 32 + 8 * fq) = w;
                    }
                    asm volatile("" ::: "memory");
                }
            if (!isq) {
#pragma unroll
                for (int bj = 0; bj < 2; ++bj)
#pragma unroll
                    for (int n = 0; n < 2; ++n) {
                        f32x4 v = ks[bj][n];
#pragma unroll
                        for (int o = 1; o < 16; o <<= 1) { v[0] += __shfl_xor(v[0], o); v[1] += __shfl_xor(v[1], o); v[2] += __shfl_xor(v[2], o); v[3] += __shfl_xor(v[3], o); }
                        if (fr == 0) *(f32x4*)(KM + (size_t)(u.pm * 2 + wr) * 1024 + hcol + bj * 128 + wc * 32 + 8 * fq + 4 * n) = v;
                    }
            }
        } else
#endif
#ifndef NO_VT
        if (pn < 12) {
            const int b = u.pm >> 5; const int tb = (u.pm & 31) * 256 + wr * 64;
            const unsigned voff = (unsigned)((8 * fq) * SEQ + fr) * 2u;
#pragma unroll
            for (int bj = 0; bj < 2; ++bj)
#pragma unroll
                for (int n = 0; n < 2; ++n)
#pragma unroll
                    for (int i = 0; i < 4; ++i) {
                        char* sb = (char*)VT + ((size_t)((b * NH + (pn - 8) * 2 + bj) * HD + 32 * wc + 4 * n + i) * SEQ + tb) * 2;
#pragma unroll
                        for (int ai = 0; ai < 2; ++ai)
#pragma unroll
                            for (int m = 0; m < 4; ++m) *(bf16_t*)(sb + voff + (ai * 128 + m * 16) * 2) = (bf16_t)(cvt_pk_bf16(acc[ai][bj][m][n][i], 0.f) & 0xffffu);
                    }
        } else
#endif
        if (pn < 14) {
#pragma unroll
            for (int ai = 0; ai < 2; ++ai)
#pragma unroll
                for (int m = 0; m < 4; ++m) { const int row = rbase + ai * 128 + m * 16;
#pragma unroll
                    for (int bj = 0; bj < 2; ++bj) { const f32x4 v0 = acc[ai][bj][m][0], v1 = acc[ai][bj][m][1];
                        u32x4 w; w.x = cvt_pk_bf16(v0[0], v0[1]); w.y = cvt_pk_bf16(v0[2], v0[3]); w.z = cvt_pk_bf16(v1[0], v1[1]); w.w = cvt_pk_bf16(v1[2], v1[3]);
                        *(u32x4*)(U + (size_t)row * SSMW + (pn - 12) * 256 + bj * 128 + wc * 32 + 8 * fq) = w; } }
        } else {
            bf16_t* G = GAB + (pn >= 18 ? (size_t)M * DM : 0); const int cb = ((pn - 14) & 3) * 256;
#pragma unroll
            for (int ai = 0; ai < 2; ++ai)
#pragma unroll
                for (int m = 0; m < 4; ++m) { const int row = rbase + ai * 128 + m * 16;
#pragma unroll
                    for (int bj = 0; bj < 2; ++bj) { const f32x4 v0 = acc[ai][bj][m][0], v1 = acc[ai][bj][m][1];
                        u32x4 w; w.x = cvt_pk_bf16(sigmoidf_(v0[0]), sigmoidf_(v0[1])); w.y = cvt_pk_bf16(sigmoidf_(v0[2]), sigmoidf_(v0[3])); w.z = cvt_pk_bf16(sigmoidf_(v1[0]), sigmoidf_(v1[1])); w.w = cvt_pk_bf16(sigmoidf_(v1[2]), sigmoidf_(v1[3]));
                        *(u32x4*)(G + (size_t)row * DM + cb + bj * 128 + wc * 32 + 8 * fq) = w; }
                    asm volatile("" ::: "memory"); }
        }
    }
};

struct EpiGlu {
    static constexpr bool PERM = true, AFTER_DRAIN = false;
    const bf16_t *GA, *GB, *OA; bf16_t* MIX;
    __device__ __forceinline__ void operator()(const f32x4 (&acc)[2][2][4][2], const Unit& u, int wr, int wc, int fr, int fq) const {
        const int rbase = u.pm * 256 + wr * 64 + fr; const int cb = u.pn * 128 + wc * 32 + 8 * fq;
#pragma unroll
        for (int ai = 0; ai < 2; ++ai) {
            u32x4 ga[4], gb[4], oa[4];
#pragma unroll
            for (int m = 0; m < 4; ++m) { const size_t off = (size_t)(rbase + ai * 128 + m * 16) * DM + cb; ga[m] = *(const u32x4*)(GA + off); gb[m] = *(const u32x4*)(GB + off); oa[m] = *(const u32x4*)(OA + off); }
#pragma unroll
            for (int m = 0; m < 4; ++m) {
                float r[8];
#pragma unroll
                for (int e = 0; e < 8; ++e) {
                    const unsigned gaw = ga[m][e >> 1], gbw = gb[m][e >> 1], oaw = oa[m][e >> 1];
                    const float fa = (e & 1) ? __uint_as_float(gaw & 0xffff0000u) : __uint_as_float(gaw << 16);
                    const float fb = (e & 1) ? __uint_as_float(gbw & 0xffff0000u) : __uint_as_float(gbw << 16);
                    const float fo = (e & 1) ? __uint_as_float(oaw & 0xffff0000u) : __uint_as_float(oaw << 16);
                    const float val = acc[ai][0][m][e >> 2][e & 3], gt = acc[ai][1][m][e >> 2][e & 3];
                    r[e] = fa * fo + fb * (val * sigmoidf_(gt));
                }
                u32x4 w; w.x = cvt_pk_bf16(r[0], r[1]); w.y = cvt_pk_bf16(r[2], r[3]); w.z = cvt_pk_bf16(r[4], r[5]); w.w = cvt_pk_bf16(r[6], r[7]);
                *(u32x4*)(MIX + (size_t)(rbase + ai * 128 + m * 16) * DM + cb) = w;
            }
        }
    }
};

struct EpiRes5 {
    static constexpr bool PERM = true, AFTER_DRAIN = false;
    const float* base; bf16_t* xb; float* SS;
    __device__ __forceinline__ void operator()(const f32x4 (&acc)[2][2][4][2], const Unit& u, int wr, int wc, int fr, int fq) const {
        const int rbase = u.pm * 256 + wr * 64 + fr; const int cb = u.pn * 256 + wc * 32 + 8 * fq;
#pragma unroll
        for (int ai = 0; ai < 2; ++ai) {
            f32x4 bs[4][2][2];
#pragma unroll
            for (int m = 0; m < 4; ++m)
#pragma unroll
                for (int bj = 0; bj < 2; ++bj) { const float* bp = base + (size_t)(rbase + ai * 128 + m * 16) * DM + cb + bj * 128; bs[m][bj][0] = *(const f32x4*)bp; bs[m][bj][1] = *(const f32x4*)(bp + 4); }
#pragma unroll
            for (int m = 0; m < 4; ++m) { const int row = rbase + ai * 128 + m * 16; float s = 0.f;
#pragma unroll
                for (int bj = 0; bj < 2; ++bj) {
                    const f32x4 v0 = bs[m][bj][0] + acc[ai][bj][m][0], v1 = bs[m][bj][1] + acc[ai][bj][m][1];
                    s += ((v0[0] * v0[0] + v0[1] * v0[1]) + (v0[2] * v0[2] + v0[3] * v0[3])) + ((v1[0] * v1[0] + v1[1] * v1[1]) + (v1[2] * v1[2] + v1[3] * v1[3]));
                    u32x4 w; w.x = cvt_pk_bf16(v0[0], v0[1]); w.y = cvt_pk_bf16(v0[2], v0[3]); w.z = cvt_pk_bf16(v1[0], v1[1]); w.w = cvt_pk_bf16(v1[2], v1[3]); *(u32x4*)(xb + (size_t)row * DM + cb + bj * 128) = w;
                }
                s += __shfl_xor(s, 16); s += __shfl_xor(s, 32); if (fq == 0) SS[(size_t)row * 16 + u.pn * 4 + wc] = s;
            }
        }
    }
};
struct EpiRes7 {
    static constexpr bool PERM = true, AFTER_DRAIN = false;
    const bf16_t* base; bf16_t* xo;
    __device__ __forceinline__ void operator()(const f32x4 (&acc)[2][2][4][2], const Unit& u, int wr, int wc, int fr, int fq) const {
        const int rbase = u.pm * 256 + wr * 64 + fr; const int cb = u.pn * 256 + wc * 32 + 8 * fq;
        u32x4 bw[2][4][2];
#pragma unroll
        for (int ai = 0; ai < 2; ++ai)
#pragma unroll
            for (int m = 0; m < 4; ++m)
#pragma unroll
                for (int bj = 0; bj < 2; ++bj) bw[ai][m][bj] = *(const u32x4*)(base + (size_t)(rbase + ai * 128 + m * 16) * DM + cb + bj * 128);
#pragma unroll
        for (int ai = 0; ai < 2; ++ai)
#pragma unroll
            for (int m = 0; m < 4; ++m)
#pragma unroll
                for (int bj = 0; bj < 2; ++bj) {
                    const u32x4 b4 = bw[ai][m][bj]; const f32x4 a0 = acc[ai][bj][m][0], a1 = acc[ai][bj][m][1];
                    u32x4 w;
                    w.x = cvt_pk_bf16(__uint_as_float(b4.x << 16) + a0[0], __uint_as_float(b4.x & 0xffff0000u) + a0[1]);
                    w.y = cvt_pk_bf16(__uint_as_float(b4.y << 16) + a0[2], __uint_as_float(b4.y & 0xffff0000u) + a0[3]);
                    w.z = cvt_pk_bf16(__uint_as_float(b4.z << 16) + a1[0], __uint_as_float(b4.z & 0xffff0000u) + a1[1]);
                    w.w = cvt_pk_bf16(__uint_as_float(b4.w << 16) + a1[2], __uint_as_float(b4.w & 0xffff0000u) + a1[3]);
                    *(u32x4*)(xo + (size_t)(rbase + ai * 128 + m * 16) * DM + cb + bj * 128) = w;
                }
    }
};

struct EpiUp {
    static constexpr bool PERM = true, AFTER_DRAIN = false;
    const float* SS; bf16_t* H;
    __device__ __forceinline__ void operator()(const f32x4 (&acc)[2][2][4][2], const Unit& u, int wr, int wc, int fr, int fq) const {
        const int rbase = u.pm * 256 + wr * 64 + fr;
        float rstd[2][4];
#pragma unroll
        for (int ai = 0; ai < 2; ++ai)
#pragma unroll
            for (int m = 0; m < 4; ++m) { const f32x4* sp = (const f32x4*)(SS + (size_t)(rbase + ai * 128 + m * 16) * 16); const f32x4 s0 = sp[0], s1 = sp[1], s2 = sp[2], s3 = sp[3];
                const float ssum = ((s0[0] + s0[1]) + (s0[2] + s0[3])) + ((s1[0] + s1[1]) + (s1[2] + s1[3])) + ((s2[0] + s2[1]) + (s2[2] + s2[3])) + ((s3[0] + s3[1]) + (s3[2] + s3[3]));
                rstd[ai][m] = 1.0f / sqrtf(ssum * (1.0f / DM) + RMS_EPS); }
#pragma unroll
        for (int ai = 0; ai < 2; ++ai)
#pragma unroll
            for (int m = 0; m < 4; ++m) { const int row = rbase + ai * 128 + m * 16;
#pragma unroll
                for (int bj = 0; bj < 2; ++bj) { f32x4 v0 = acc[ai][bj][m][0] * rstd[ai][m], v1 = acc[ai][bj][m][1] * rstd[ai][m];
#pragma unroll
                    for (int i = 0; i < 4; ++i) { const float r0 = fmaxf(v0[i], 0.f), r1 = fmaxf(v1[i], 0.f); v0[i] = r0 * r0; v1[i] = r1 * r1; }
                    u32x4 w; w.x = cvt_pk_bf16(v0[0], v0[1]); w.y = cvt_pk_bf16(v0[2], v0[3]); w.z = cvt_pk_bf16(v1[0], v1[1]); w.w = cvt_pk_bf16(v1[2], v1[3]);
                    *(u32x4*)(H + (size_t)row * FF + u.pn * 256 + bj * 128 + wc * 32 + 8 * fq) = w; } }
    }
};

__device__ __forceinline__ int src_col(int kind, int j) {
    if (kind == 0) { if (j < 2048) { const int p = j & 127; return (j & ~127) + 64 * ((p >> 2) & 1) + 16 * (p >> 5) + 4 * ((p >> 3) & 3) + (p & 3); } return j; }
    if (kind == 1) { const int h = j >> 8, r = j & 255; return r < 128 ? h * 128 + r : 1024 + h * 128 + (r - 128); }
    return j;
}
__device__ __forceinline__ void transpose_item(const float* W, int K, int Nsrc, int Ndst, bf16_t* WT, int kind, const float* kscale, float* scr, int item, int lane) {
    const int nblk = Ndst / 32, kb = item / nblk, nb = item % nblk, k0 = 64 * kb, j0 = 32 * nb;
    const int sc = src_col(kind, j0 + (lane & 31));
    float tv[32];
#pragma unroll
    for (int i = 0; i < 32; ++i) { const int kk = 2 * i + (lane >> 5); tv[i] = W[(size_t)(k0 + kk) * Nsrc + sc]; }
#pragma unroll
    for (int i = 0; i < 32; ++i) { const int kk = 2 * i + (lane >> 5); float v = tv[i]; if (kscale) v *= kscale[k0 + kk]; scr[kk * 33 + (lane & 31)] = v; }
    __builtin_amdgcn_s_waitcnt(0); __builtin_amdgcn_wave_barrier();
    const int c = lane & 7;
#pragma unroll
    for (int jj = 0; jj < 4; ++jj) { const int n = (lane >> 3) + 8 * jj; const float* s = scr + (8 * c) * 33 + n;
        u32x4 o; o.x = cvt_pk_bf16(s[0 * 33], s[1 * 33]); o.y = cvt_pk_bf16(s[2 * 33], s[3 * 33]); o.z = cvt_pk_bf16(s[4 * 33], s[5 * 33]); o.w = cvt_pk_bf16(s[6 * 33], s[7 * 33]);
        *(u32x4*)(WT + (size_t)(j0 + n) * K + k0 + 8 * c) = o; }
    __builtin_amdgcn_s_waitcnt(0); __builtin_amdgcn_wave_barrier();
}

constexpr int S2_TB = 0, S2_TC = 4096, S2_TA = 4096 + 8704, S2_DS = S2_TA + 2560, S2_XL = S2_DS + 64, S2_XLW = 32 * 272;
constexpr int NCHUNK = 16, CHUNK = 512;
__device__ __forceinline__ void ssm_tables(const Params& p, int g, char* lds, int tid) {
    bf16_t* TB = (bf16_t*)(lds + S2_TB); float* TA = (float*)(lds + S2_TA); float* DS = (float*)(lds + S2_DS);
    const float step = expf(p.in[5][g]);
    for (int e = tid; e < 128 * 16; e += 512) {
        const int j = e >> 4, ch = e & 15, q = j >> 5, n = (q >> 1) * 32 + (j & 31);
        const float lr = p.in[3][g * 64 + n], li = p.in[4][g * 64 + n];
        const float mag = expf(lr * step); float sn, cs; sincosf(li * step, &sn, &cs);
        const float ar = mag * cs, ai = mag * sn, den = lr * lr + li * li, nr = ar - 1.0f, ni = ai;
        const float cr = (nr * lr + ni * li) / den, ci = (ni * lr - nr * li) / den;
        const float bre = p.in[6][(g * 64 + n) * 16 + ch], bim = p.in[7][(g * 64 + n) * 16 + ch];
        const float v = (q & 1) ? (cr * bim + ci * bre) : (cr * bre - ci * bim);
        TB[e] = (bf16_t)(cvt_pk_bf16(v, 0.f) & 0xffffu);
    }
    for (int e = tid; e < 32 * 128; e += 512) {
        const int c = e >> 7, j = e & 127, n = 32 * (j >> 6) + ((j & 63) >> 1);
        float v = 0.f;
        if (c < 16) v = (j & 1) ? -p.in[9][(g * 16 + c) * 64 + n] : p.in[8][(g * 16 + c) * 64 + n];
        *(bf16_t*)(lds + S2_TC + c * 272 + j * 2) = (bf16_t)(cvt_pk_bf16(v, 0.f) & 0xffffu);
    }
    if (tid < 64) {
        const int n = tid; const float lr = p.in[3][g * 64 + n], li = p.in[4][g * 64 + n];
        const float mag = expf(lr * step); float sn, cs; sincosf(li * step, &sn, &cs);
        const float a1r = mag * cs, a1i = mag * sn;
        const float a2r = a1r * a1r - a1i * a1i, a2i = 2.f * a1r * a1i;
        const float a3r = a2r * a1r - a2i * a1i, a3i = a2r * a1i + a2i * a1r;
        const float a4r = a2r * a2r - a2i * a2i, a4i = 2.f * a2r * a2i;
        float pr = a4r, pi = a4i;
#pragma unroll
        for (int k = 0; k < 7; ++k) { const float tr = pr * pr - pi * pi, ti = 2.f * pr * pi; pr = tr; pi = ti; }
        float* o = TA + n * 10; o[0] = a1r; o[1] = a1i; o[2] = a2r; o[3] = a2i; o[4] = a3r; o[5] = a3i; o[6] = a4r; o[7] = a4i; o[8] = pr; o[9] = pi;
    }
    if (tid < 16) DS[tid] = p.in[10][g * 16 + tid];
}
template <bool FULL>
__device__ __forceinline__ void ssm_chunk(const Params& p, int b, int g, int ck, char* lds, int wid, int lane) {
    const int r32 = lane & 31, hi = lane >> 5;
    const bf16_t* U = (const bf16_t*)(p.ws + WS_U); float* AGG = (float*)(p.ws + WS_AGG); bf16_t* Y = (bf16_t*)(p.ws + WS_Y);
    const float* TA = (const float*)(lds + S2_TA); const float* DS = (const float*)(lds + S2_DS);
    char* XL = lds + S2_XL + wid * S2_XLW;
    bf16x8 tbf[4];
#pragma unroll
    for (int q = 0; q < 4; ++q) tbf[q] = *(const bf16x8*)(lds + S2_TB + ((32 * q + r32) * 16 + 8 * hi) * 2);
    float ar[2][4], ai[2][4], bgr[2], bgi[2];
#pragma unroll
    for (int pr = 0; pr < 2; ++pr) { const float* o = TA + (32 * pr + r32) * 10;
#pragma unroll
        for (int k = 0; k < 4; ++k) { ar[pr][k] = o[2 * k]; ai[pr][k] = o[2 * k + 1]; } bgr[pr] = o[8]; bgi[pr] = o[9]; }
    float cr[2] = {0.f, 0.f}, ci[2] = {0.f, 0.f};
    if (FULL) {
        float sr[2][NCHUNK - 1], si[2][NCHUNK - 1];
#pragma unroll
        for (int c2 = 0; c2 < NCHUNK - 1; ++c2)
#pragma unroll
            for (int pr = 0; pr < 2; ++pr) { const float* ag = AGG + (((size_t)(b * NG + g) * NCHUNK + c2) * 64 + 32 * pr + r32) * 2; const f32x2 v = *(const f32x2*)ag; sr[pr][c2] = v.x; si[pr][c2] = v.y; }
#pragma unroll
        for (int c2 = 0; c2 < NCHUNK - 1; ++c2)
            if (c2 < ck) {
#pragma unroll
                for (int pr = 0; pr < 2; ++pr) { const float nr = bgr[pr] * cr[pr] - bgi[pr] * ci[pr] + sr[pr][c2], ni = bgr[pr] * ci[pr] + bgi[pr] * cr[pr] + si[pr][c2]; cr[pr] = nr; ci[pr] = ni; }
            }
    }
    const int row0 = b * SEQ + ck * CHUNK;
    bf16x8 ubn = *(const bf16x8*)(U + (size_t)(row0 + r32) * SSMW + g * 16 + 8 * hi);
#pragma unroll 1
    for (int tl = 0; tl < CHUNK / 32; ++tl) {
        const int row = row0 + 32 * tl + r32;
        const bf16x8 ub = ubn;
        { const int tn = tl + 1 < CHUNK / 32 ? tl + 1 : tl; ubn = *(const bf16x8*)(U + (size_t)(row0 + 32 * tn + r32) * SSMW + g * 16 + 8 * hi); }
#pragma unroll
        for (int pr = 0; pr < 2; ++pr) {
            const f32x16 xr = __builtin_amdgcn_mfma_f32_32x32x16_bf16(ub, tbf[2 * pr], f32x16{}, 0, 0, 0);
            const f32x16 xi = __builtin_amdgcn_mfma_f32_32x32x16_bf16(ub, tbf[2 * pr + 1], f32x16{}, 0, 0, 0);
#define CMADD(acc, A0, A1, pp) ((acc) + (A0) * (pp) + (A1) * __builtin_shufflevector((pp), (pp), 1, 0))
            f32x2 z[16];
#pragma unroll
            for (int r = 0; r < 16; ++r) z[r] = (f32x2){xr[r], xi[r]};
            const f32x2 a1s = {ar[pr][0], ar[pr][0]}, a1x = {-ai[pr][0], ai[pr][0]}, a4s = {ar[pr][3], ar[pr][3]}, a4x = {-ai[pr][3], ai[pr][3]};
#pragma unroll
            for (int q = 0; q < 4; ++q)
#pragma unroll
                for (int k = 1; k < 4; ++k) { const int r = 4 * q + k; z[r] = CMADD(z[r], a1s, a1x, z[r - 1]); }
            f32x2 C = {cr[pr], ci[pr]}; f32x2 my[4];
#pragma unroll
            for (int q = 0; q < 4; ++q) {
                const auto swr = __builtin_amdgcn_permlane32_swap(__float_as_uint(z[4 * q + 3].x), __float_as_uint(z[4 * q + 3].x), false, false);
                const auto swi = __builtin_amdgcn_permlane32_swap(__float_as_uint(z[4 * q + 3].y), __float_as_uint(z[4 * q + 3].y), false, false);
                const f32x2 e0 = {__uint_as_float(swr[0]), __uint_as_float(swi[0])}, e1 = {__uint_as_float(swr[1]), __uint_as_float(swi[1])};
                const f32x2 c0 = C; C = CMADD(e0, a4s, a4x, C);
                const f32x2 c1 = C; C = CMADD(e1, a4s, a4x, C);
                my[q] = hi ? c1 : c0;
            }
            cr[pr] = C.x; ci[pr] = C.y;
            if (FULL) {
#pragma unroll
                for (int k = 0; k < 4; ++k) { const f32x2 aks = {ar[pr][k], ar[pr][k]}, akx = {-ai[pr][k], ai[pr][k]};
#pragma unroll
                    for (int q = 0; q < 4; ++q) { const int r = 4 * q + k; z[r] = CMADD(z[r], aks, akx, my[q]); } }
#pragma unroll
                for (int r = 0; r < 16; ++r) *(unsigned*)(XL + crow(r, hi) * 272 + 128 * pr + 4 * r32) = cvt_pk_bf16(z[r].x, z[r].y);
            }
#undef CMADD
        }
        if (FULL) {
            f32x16 ya = {};
#pragma unroll
            for (int s2 = 0; s2 < 8; ++s2) {
                const bf16x8 xb = *(const bf16x8*)(XL + r32 * 272 + (16 * s2 + 8 * hi) * 2);
                const bf16x8 tc = *(const bf16x8*)(lds + S2_TC + r32 * 272 + (16 * s2 + 8 * hi) * 2);
                ya = __builtin_amdgcn_mfma_f32_32x32x16_bf16(tc, xb, ya, 0, 0, 0);
            }
#pragma unroll
            for (int h2 = 0; h2 < 2; ++h2) {
                const int c0 = 8 * h2 + 4 * hi;
                u32x2 uw;
                { const u32x4 ud = __builtin_bit_cast(u32x4, ub);
                  const auto s0 = __builtin_amdgcn_permlane32_swap(ud[0], ud[2], false, false); const auto s1 = __builtin_amdgcn_permlane32_swap(ud[1], ud[3], false, false);
                  const unsigned own0 = hi ? ud[2] : ud[0], own1 = hi ? ud[3] : ud[1], oth0 = hi ? s0[0] : s0[1], oth1 = hi ? s1[0] : s1[1];
                  uw.x = (h2 == hi) ? own0 : oth0; uw.y = (h2 == hi) ? own1 : oth1; }
                const float uu[4] = {__uint_as_float(uw.x << 16), __uint_as_float(uw.x & 0xffff0000u), __uint_as_float(uw.y << 16), __uint_as_float(uw.y & 0xffff0000u)};
                float v[4];
#pragma unroll
                for (int k = 0; k < 4; ++k) { const float yy = ya[4 * h2 + k] + DS[c0 + k] * uu[k];
                    v[k] = yy * __builtin_amdgcn_rcpf(1.0f + __builtin_amdgcn_exp2f(-2.3022082f * (yy + 0.044715f * yy * yy * yy))); }
                u32x2 w; w.x = cvt_pk_bf16(v[0], v[1]); w.y = cvt_pk_bf16(v[2], v[3]);
                *(u32x2*)(Y + (size_t)row * SSMW + g * 16 + c0) = w;
            }
        }
    }
    if (!FULL) { if (hi == 0) {
#pragma unroll
        for (int pr = 0; pr < 2; ++pr) { float* ag = AGG + (((size_t)(b * NG + g) * NCHUNK + ck) * 64 + 32 * pr + r32) * 2; ag[0] = cr[pr]; ag[1] = ci[pr]; } } }
}
template <bool FULL>
__device__ __forceinline__ void ssm_phase(const Params& p, char* lds, int tid, int wid, int lane) {
    int tid_o = threadIdx.x; asm volatile("" : "+v"(tid_o)); tid = tid_o; lane = tid_o & 63; wid = __builtin_amdgcn_readfirstlane(tid_o >> 6);
    for (int it = blockIdx.x; it < NG * BATCH * 2; it += gridDim.x) {
        const int g = it >> 3, b = (it >> 1) & 3, h2 = it & 1;
        __syncthreads();
        ssm_tables(p, g, lds, tid);
        __syncthreads();
        ssm_chunk<FULL>(p, b, g, h2 * 8 + wid, lds, wid, lane);
    }
    __syncthreads();
}

__device__ __forceinline__ void gating_phase(const Params& p, char* lds, int tid) {
    { int tid_o = threadIdx.x; asm volatile("" : "+v"(tid_o)); tid = tid_o; }
    float* km = (float*)lds;
    const float* KM = (const float*)(p.ws + WS_KM); const bf16_t* Q = (const bf16_t*)(p.ws + WS_Q); unsigned* SEL = (unsigned*)(p.ws + WS_SEL);
    for (int it = blockIdx.x; it < 32 * 16; it += gridDim.x) {
        const int bh = it >> 4, tc = (it & 15) ^ (((it >> 8) & 1) ? 15 : 0), b = bh >> 3, h = bh & 7;
        __syncthreads();
        for (int e = tid; e < 32 * 128; e += 512) { const int n = e >> 7, d = e & 127;
            km[e] = (KM[(size_t)((b * 32 + n) * 2 + 0) * 1024 + h * 128 + d] + KM[(size_t)((b * 32 + n) * 2 + 1) * 1024 + h * 128 + d]) * (1.0f / 256.0f); }
        __syncthreads();
        const int t = tc * 512 + tid, qb = t >> 8;
        unsigned sel;
        if (qb < 4) { sel = qb == 0 ? 0xffffffu : qb == 1 ? 0xffff00u : qb == 2 ? 0xff0100u : 0x020100u; }
        else {
            float q[128];
            const u32x4* qp = (const u32x4*)(Q + (size_t)(b * SEQ + t) * DM + h * 128);
            float v0 = -INFINITY, v1 = -INFINITY, v2 = -INFINITY; int i0 = 255, i1 = 255, i2 = 255;
            unsigned qw[64];
#pragma unroll
            for (int j = 0; j < 16; ++j) { const u32x4 w = qp[j]; qw[4 * j] = w.x; qw[4 * j + 1] = w.y; qw[4 * j + 2] = w.z; qw[4 * j + 3] = w.w; }
            (void)q;
            for (int n = 0; n < qb; ++n) {
                const f32x4* kp = (const f32x4*)(km + n * 128); float g0 = 0.f, g1 = 0.f;
#pragma unroll
                for (int j = 0; j < 32; ++j) { const f32x4 kv = kp[j];
                    g0 += __uint_as_float(qw[2 * j] << 16) * kv[0] + __uint_as_float(qw[2 * j + 1] << 16) * kv[2];
                    g1 += __uint_as_float(qw[2 * j] & 0xffff0000u) * kv[1] + __uint_as_float(qw[2 * j + 1] & 0xffff0000u) * kv[3]; }
                const float gte = g0 + g1;
                if (gte > v0) { v2 = v1; i2 = i1; v1 = v0; i1 = i0; v0 = gte; i0 = n; }
                else if (gte > v1) { v2 = v1; i2 = i1; v1 = gte; i1 = n; }
                else if (gte > v2) { v2 = gte; i2 = n; }
            }
            sel = (unsigned)i0 | ((unsigned)i1 << 8) | ((unsigned)i2 << 16);
        }
        SEL[(size_t)bh * SEQ + t] = sel;
    }
    __syncthreads();
}

constexpr int KP = 272, VP = 520;
constexpr int ATT_K = 0, ATT_V = 256 * KP, ATT_LIST = ATT_V + 128 * VP, ATT_MISC = ATT_LIST + 16384;
__device__ __forceinline__ void stage_kv(const Params& p, int b, int h, int n, char* lds, int tid) {
    const bf16_t* Kg = (const bf16_t*)(p.ws + WS_K) + (size_t)(b * SEQ + n * BLK) * DM + h * HD;
    const bf16_t* Vg = (const bf16_t*)(p.ws + WS_VT) + (size_t)(b * NH + h) * HD * SEQ + n * BLK;
#ifndef STAGE_OLD
    u32x4 kk[8], vv[8];
#pragma unroll
    for (int i = 0; i < 8; ++i) { const int c = tid + i * 512; kk[i] = *(const u32x4*)(Kg + (size_t)(c >> 4) * DM + (c & 15) * 8); vv[i] = *(const u32x4*)(Vg + (size_t)(c >> 5) * SEQ + (c & 31) * 8); }
#pragma unroll
    for (int i = 0; i < 8; ++i) { const int c = tid + i * 512; *(u32x4*)(lds + ATT_K + (c >> 4) * KP + (c & 15) * 16) = kk[i]; { char* vd = lds + ATT_V + (c >> 5) * VP + (c & 31) * 16; *(u32x2*)vd = (u32x2){vv[i].x, vv[i].y}; *(u32x2*)(vd + 8) = (u32x2){vv[i].z, vv[i].w}; } }
#else
#pragma unroll
    for (int i = 0; i < 8; ++i) { const int c = tid + i * 512, r = c >> 4, cc = c & 15; *(u32x4*)(lds + ATT_K + r * KP + cc * 16) = *(const u32x4*)(Kg + (size_t)r * DM + cc * 8); }
#pragma unroll
    for (int i = 0; i < 8; ++i) { const int c = tid + i * 512, r = c >> 5, cc = c & 31; *(u32x4*)(lds + ATT_V + r * VP + cc * 16) = *(const u32x4*)(Vg + (size_t)r * SEQ + cc * 8); }
#endif
}
template <bool CAUSAL>
__device__ __forceinline__ void attn_tile(const char* lds, const bf16x8 (&qf)[8], int qoff, int nchunks, f32x16 (&o)[4], float& m, float& l, int r32, int hi) {
#pragma unroll 4
    for (int c = 0; c < nchunks; ++c) {
        f32x16 s0 = {}, s1 = {};
        const char* kb = lds + ATT_K + (64 * c + r32) * KP + hi * 128;
        {
            bf16x8 ka[4], kc[4];
#pragma unroll
            for (int ks = 0; ks < 4; ++ks) { ka[ks] = *(const bf16x8*)(kb + ks * 16); kc[ks] = *(const bf16x8*)(kb + 32 * KP + ks * 16); }
            __builtin_amdgcn_sched_barrier(0);
            bf16x8 kd[4], ke[4];
#pragma unroll
            for (int ks = 0; ks < 4; ++ks) { kd[ks] = *(const bf16x8*)(kb + (ks + 4) * 16); ke[ks] = *(const bf16x8*)(kb + 32 * KP + (ks + 4) * 16);
                s0 = __builtin_amdgcn_mfma_f32_32x32x16_bf16(ka[ks], qf[ks], s0, 0, 0, 0);
                s1 = __builtin_amdgcn_mfma_f32_32x32x16_bf16(kc[ks], qf[ks], s1, 0, 0, 0); }
            __builtin_amdgcn_sched_barrier(0);
#pragma unroll
            for (int ks = 0; ks < 4; ++ks) {
                s0 = __builtin_amdgcn_mfma_f32_32x32x16_bf16(kd[ks], qf[ks + 4], s0, 0, 0, 0);
                s1 = __builtin_amdgcn_mfma_f32_32x32x16_bf16(ke[ks], qf[ks + 4], s1, 0, 0, 0); }
        }
        if (CAUSAL && c == nchunks - 1) {
#pragma unroll
            for (int r = 0; r < 16; ++r) { const int key = 64 * c + crow(r, hi); if (key > qoff) s0[r] = -INFINITY; if (key + 32 > qoff) s1[r] = -INFINITY; }
        }
#define MX3(a, b, c) __builtin_fmaxf(__builtin_fmaxf((a), (b)), (c))
        float cm = MX3(s0[0], s0[1], s0[2]), cm2 = MX3(s1[0], s1[1], s1[2]);
#pragma unroll
        for (int r = 3; r < 15; r += 2) { cm = MX3(cm, s0[r], s0[r + 1]); cm2 = MX3(cm2, s1[r], s1[r + 1]); }
        cm = MX3(cm, s0[15], s1[15]); cm = __builtin_fmaxf(cm, cm2);
#undef MX3
        { const auto rr = __builtin_amdgcn_permlane32_swap(__float_as_uint(cm), __float_as_uint(cm), false, false); cm = __builtin_fmaxf(__uint_as_float(rr[0]), __uint_as_float(rr[1])); }
        if (__any(cm > m + 12.0f)) {
            const float mn = (cm > m + 12.0f) ? cm : m;
            const float alpha = __builtin_amdgcn_exp2f(m - mn); m = mn; l *= alpha;
#pragma unroll
            for (int dt = 0; dt < 4; ++dt)
#pragma unroll
                for (int r = 0; r < 16; ++r) o[dt][r] *= alpha;
        }
        float ls = 0.f;
#pragma unroll
        for (int r = 0; r < 16; ++r) { s0[r] = __builtin_amdgcn_exp2f(s0[r] - m); s1[r] = __builtin_amdgcn_exp2f(s1[r] - m); ls += s0[r] + s1[r]; }
        l += ls;
        bf16x8 pb[2][2];
#pragma unroll
        for (int kk = 0; kk < 2; ++kk) {
            u32x4 w0, w1;
#pragma unroll
            for (int j = 0; j < 4; ++j) { w0[j] = cvt_pk_bf16(s0[8 * kk + 2 * j], s0[8 * kk + 2 * j + 1]); w1[j] = cvt_pk_bf16(s1[8 * kk + 2 * j], s1[8 * kk + 2 * j + 1]); }
            pb[0][kk] = __builtin_bit_cast(bf16x8, w0); pb[1][kk] = __builtin_bit_cast(bf16x8, w1);
        }
#pragma unroll
        for (int dp = 0; dp < 2; ++dp) {
            u32x2 vf[2][2][2][2];
#pragma unroll
            for (int d2 = 0; d2 < 2; ++d2) { const char* vb = lds + ATT_V + (32 * (2 * dp + d2) + r32) * VP + (64 * c + 4 * hi) * 2;
#pragma unroll
                for (int hh = 0; hh < 2; ++hh)
#pragma unroll
                    for (int kk = 0; kk < 2; ++kk) { vf[d2][hh][kk][0] = *(const u32x2*)(vb + (32 * hh + 16 * kk) * 2); vf[d2][hh][kk][1] = *(const u32x2*)(vb + (32 * hh + 16 * kk + 8) * 2); } }
            __builtin_amdgcn_sched_barrier(0);
#pragma unroll
            for (int d2 = 0; d2 < 2; ++d2)
#pragma unroll
                for (int hh = 0; hh < 2; ++hh)
#pragma unroll
                    for (int kk = 0; kk < 2; ++kk) {
                        const u32x4 a = {vf[d2][hh][kk][0].x, vf[d2][hh][kk][0].y, vf[d2][hh][kk][1].x, vf[d2][hh][kk][1].y};
                        o[2 * dp + d2] = __builtin_amdgcn_mfma_f32_32x32x16_bf16(__builtin_bit_cast(bf16x8, a), pb[hh][kk], o[2 * dp + d2], 0, 0, 0);
                    }
        }
    }
}
__device__ __forceinline__ void load_q(const Params& p, int row, int h, int hi, bf16x8 (&qf)[8]) {
    const bf16_t* qp = (const bf16_t*)(p.ws + WS_Q) + (size_t)row * DM + h * HD + hi * 64;
#pragma unroll
    for (int ks = 0; ks < 8; ++ks) qf[ks] = *(const bf16x8*)(qp + ks * 8);
}

__device__ __forceinline__ void store_partial(bf16_t* po, const f32x16 (&o)[4], float inv) {
#pragma unroll
    for (int dt = 0; dt < 4; ++dt) {
        u32x4 w0, w1;
#pragma unroll
        for (int j = 0; j < 4; ++j) { w0[j] = cvt_pk_bf16(o[dt][2 * j] * inv, o[dt][2 * j + 1] * inv); w1[j] = cvt_pk_bf16(o[dt][8 + 2 * j] * inv, o[dt][8 + 2 * j + 1] * inv); }
        *(u32x4*)(po + dt * 16) = w0; *(u32x4*)(po + dt * 16 + 8) = w1;
    }
}
__device__ __forceinline__ void attn_gather_phase(const Params& p, char* lds, int tid, int wid, int lane, int cidx = 64) {
    int tid_o = threadIdx.x; asm volatile("" : "+v"(tid_o)); tid = tid_o; lane = tid_o & 63; wid = __builtin_amdgcn_readfirstlane(tid_o >> 6);
    const int r32 = lane & 31, hi = lane >> 5;
    if (wid >= 4) __builtin_amdgcn_s_setprio(1);
    unsigned short* list = (unsigned short*)(lds + ATT_LIST); int* misc = (int*)(lds + ATT_MISC);
    const unsigned* SEL = (const unsigned*)(p.ws + WS_SEL); unsigned* ctl = (unsigned*)(p.ws + WS_CTL);
    bf16_t* PO = (bf16_t*)(p.ws + WS_PO); float* ML = (float*)(p.ws + WS_ML); bf16_t* KB = (bf16_t*)(p.ws + WS_K);
    for (;;) {
        __syncthreads();
        if (tid == 0) { misc[0] = (int)atomicAdd(ctl + cidx, 1u); misc[1] = 0; }
        __syncthreads();
        const int item = misc[0];
        if (item >= 32 * 32) break;
        const int n = item >> 5, bh = item & 31, b = bh >> 3, h = bh & 7;
        stage_kv(p, b, h, n, lds, tid);
#pragma unroll 1
        for (int i0 = 0; i0 < 16; i0 += 4) {
            if (256 * (n + 1) + i0 * 512 >= SEQ) break;
            unsigned sw[4];
#pragma unroll
            for (int i = 0; i < 4; ++i) { const int t = 256 * (n + 1) + tid + (i0 + i) * 512; sw[i] = t < SEQ ? SEL[(size_t)bh * SEQ + t] : 0xffffffffu; }
#pragma unroll
            for (int i = 0; i < 4; ++i) { const int t = 256 * (n + 1) + tid + (i0 + i) * 512; const unsigned w = sw[i];
                const int slot = ((w & 255u) == (unsigned)n) ? 0 : (((w >> 8) & 255u) == (unsigned)n) ? 1 : (((w >> 16) & 255u) == (unsigned)n) ? 2 : -1;
                if (slot >= 0) { const int idx = atomicAdd(&misc[1], 1); list[idx] = (unsigned short)(t | (slot << 13)); } }
        }
        __syncthreads();
        const int cnt = misc[1], ntiles = (cnt + 31) >> 5;
        for (int T = wid; T < ntiles + 8; T += 8) {
            f32x16 o[4]; o[0] = f32x16{}; o[1] = f32x16{}; o[2] = f32x16{}; o[3] = f32x16{};
            float m = -INFINITY, l = 0.f;
            if (T < ntiles) {
                const int ei = T * 32 + r32; const bool valid = ei < cnt;
                const unsigned e = list[valid ? ei : cnt - 1]; const int t = e & 0x1fff, slot = e >> 13; const int row = b * SEQ + t;
                bf16x8 qf[8]; load_q(p, row, h, hi, qf);
                attn_tile<false>(lds, qf, 0, 4, o, m, l, r32, hi);
                l += __shfl_xor(l, 32);
                if (valid) {
                    store_partial(PO + (size_t)slot * M * DM + (size_t)row * DM + h * HD + hi * 64, o, 1.0f / l);
                    if (hi == 0) { float* ml = ML + ((size_t)slot * M * NH + (size_t)row * NH + h) * 2; ml[0] = m; ml[1] = l; }
                }
            } else {
                const int w2 = T - ntiles, qoff = w2 * 32 + r32, row = b * SEQ + n * BLK + qoff;
                bf16x8 qf[8]; load_q(p, row, h, hi, qf);
                attn_tile<true>(lds, qf, qoff, (w2 >> 1) + 1, o, m, l, r32, hi);
                l += __shfl_xor(l, 32);
                store_partial(KB + (size_t)row * DM + h * HD + hi * 64, o, 1.0f / l);
                if (hi == 0) { float* ml = ML + ((size_t)3 * M * NH + (size_t)row * NH + h) * 2; ml[0] = m; ml[1] = l; }
            }
        }
    }
    __builtin_amdgcn_s_setprio(0);
    __syncthreads();
}
__device__ __forceinline__ void attn_merge_phase(const Params& p, int tid, int wid, int lane) {
    int tid_o = threadIdx.x; asm volatile("" : "+v"(tid_o)); tid = tid_o; lane = tid_o & 63; wid = __builtin_amdgcn_readfirstlane(tid_o >> 6);
    const int c = lane & 15, rl = lane >> 4;
    const unsigned* SEL = (const unsigned*)(p.ws + WS_SEL);
    const bf16_t* PO = (const bf16_t*)(p.ws + WS_PO); const bf16_t* KB = (const bf16_t*)(p.ws + WS_K); const float* ML = (const float*)(p.ws + WS_ML); bf16_t* OA = (bf16_t*)(p.ws + WS_Q);
    const int gw = blockIdx.x * 8 + wid, NGW = gridDim.x * 8;
    const int dcol = 32 * ((c >> 1) & 3) + 16 * (c & 1) + 4 * (c >> 3);
#pragma unroll 4
    for (int task = gw; task < (M / 4) * NH; task += NGW) {
        const int h = task & 7, row = (task >> 3) * 4 + rl, b = row >> 13, t = row & (SEQ - 1);
        const size_t rowoff = (size_t)row * DM + h * HD;
        const unsigned sw = SEL[(size_t)(b * NH + h) * SEQ + t];
        u32x4 w[4]; f32x2 ml[4];
#pragma unroll
        for (int j = 0; j < 4; ++j) { ml[j] = *(const f32x2*)(ML + ((size_t)j * M * NH + (size_t)row * NH + h) * 2); w[j] = *(const u32x4*)((j == 3 ? KB : PO + (size_t)j * M * DM) + rowoff + 8 * c); }
        float mx = ml[3].x; float mj[4], lj[4];
#pragma unroll
        for (int j = 0; j < 4; ++j) { const bool v = j == 3 || ((sw >> (8 * j)) & 255u) != 255u; mj[j] = v ? ml[j].x : -INFINITY; lj[j] = v ? ml[j].y : 0.f; mx = fmaxf(mx, mj[j]); }
        float v[8], den = 0.f;
#pragma unroll
        for (int e = 0; e < 8; ++e) v[e] = 0.f;
#pragma unroll
        for (int j = 0; j < 4; ++j) { const float f = __builtin_amdgcn_exp2f(mj[j] - mx) * lj[j]; den += f;
            if (f != 0.f) {
#pragma unroll
                for (int q = 0; q < 4; ++q) { v[2 * q] += f * __uint_as_float(w[j][q] << 16); v[2 * q + 1] += f * __uint_as_float(w[j][q] & 0xffff0000u); } } }
        const float inv = 1.0f / den;
        u32x2 o0, o1; o0.x = cvt_pk_bf16(v[0] * inv, v[1] * inv); o0.y = cvt_pk_bf16(v[2] * inv, v[3] * inv); o1.x = cvt_pk_bf16(v[4] * inv, v[5] * inv); o1.y = cvt_pk_bf16(v[6] * inv, v[7] * inv);
        *(u32x2*)(OA + rowoff + dcol) = o0; *(u32x2*)(OA + rowoff + dcol + 8) = o1;
    }
}

#define LAS __attribute__((address_space(3)))
#define XB_TMO      128
#define XB_XCNT(j)  (256  + 64 * (j))
#define XB_XSUB(j)  (1280 + 64 * (j))
#define XB_XGEN(j)  (2304 + 64 * (j))
#define XB_TOP      3328
#define XB_TOPGEN   3392
#define XCD_BAR_WORDS 3456
#define XB_SPIN_CAP (1u << 18)
__device__ __forceinline__ unsigned xb_ld(unsigned* p)              { return __hip_atomic_load(p, __ATOMIC_RELAXED, __HIP_MEMORY_SCOPE_AGENT); }
__device__ __forceinline__ unsigned xb_add(unsigned* p, unsigned v) { return __hip_atomic_fetch_add(p, v, __ATOMIC_RELAXED, __HIP_MEMORY_SCOPE_AGENT); }
__device__ __forceinline__ unsigned xb_xcc_id() { return (unsigned)__builtin_amdgcn_s_getreg((3 << 11) | 20) & 0xFu; }
#define XB_SPIN(cond, bar) do { unsigned _sp = 0; while (cond) { __builtin_amdgcn_s_sleep(1); \
    if ((++_sp & 255u) == 0u) { if (xb_ld(&(bar)[XB_TMO])) break; if (_sp > XB_SPIN_CAP) { atomicAdd(&(bar)[XB_TMO], 1u); break; } } } } while (0)
struct XcdBarrier { unsigned* bar; unsigned x; volatile LAS unsigned* st; };
__device__ __forceinline__ XcdBarrier xcd_barrier_post(unsigned* bar, volatile LAS unsigned* st) {
    XcdBarrier b; b.bar = bar; b.x = xb_xcc_id(); b.st = st;
    if (threadIdx.x == 0) (void)xb_add(&bar[XB_XCNT(b.x)], 1u);
    return b;
}
__device__ __forceinline__ void xcd_barrier_complete(unsigned* bar, unsigned x, unsigned& nloc, unsigned& nx) {
    const unsigned G = gridDim.x * gridDim.y * gridDim.z;
    unsigned sum, cnt, mine, sp = 0u;
    for (;;) {
        sum = 0u; cnt = 0u; mine = 0u;
#pragma unroll
        for (unsigned j = 0; j < 16; ++j) { const unsigned c = xb_ld(&bar[XB_XCNT(j)]); sum += c; cnt += (c > 0u) ? 1u : 0u; mine = (j == x) ? c : mine; }
        if (sum == G) break;
        __builtin_amdgcn_s_sleep(1);
        if ((++sp & 255u) == 0u) { if (xb_ld(&bar[XB_TMO])) break; if (sp > XB_SPIN_CAP) { atomicAdd(&bar[XB_TMO], 1u); break; } }
    }
    nloc = mine > 0u ? mine : 1u; nx = cnt > 0u ? cnt : 1u;
}
__device__ __forceinline__ void xcd_barrier(const XcdBarrier& b) {
    asm volatile("s_waitcnt vmcnt(0)" ::: "memory");
    __syncthreads();
    if (threadIdx.x == 0) {
        unsigned* bar = b.bar;
        __builtin_amdgcn_s_waitcnt(0);
        unsigned nloc = b.st[0], nx = b.st[1];
        if (nloc == 0u) { xcd_barrier_complete(bar, b.x, nloc, nx); b.st[0] = nloc; b.st[1] = nx; }
        const unsigned old = xb_add(&bar[XB_XSUB(b.x)], 1u);
        const unsigned gen = old / nloc;
        if (old + 1u == (gen + 1u) * nloc) {
            __builtin_amdgcn_fence(__ATOMIC_RELEASE, "agent");
            asm volatile("s_waitcnt vmcnt(0)" ::: "memory");
            const unsigned og = xb_add(&bar[XB_TOP], 1u);
            const unsigned tg = og / nx;
            if (og + 1u == (tg + 1u) * nx) xb_add(&bar[XB_TOPGEN], 1u);
            else XB_SPIN(xb_ld(&bar[XB_TOPGEN]) == tg, bar);
            __builtin_amdgcn_fence(__ATOMIC_ACQUIRE, "agent");
            xb_add(&bar[XB_XGEN(b.x)], 1u);
            asm volatile("s_waitcnt vmcnt(0)" ::: "memory");
        } else {
            XB_SPIN(xb_ld(&bar[XB_XGEN(b.x)]) == gen, bar);
            __builtin_amdgcn_fence(__ATOMIC_ACQUIRE, "agent");
            asm volatile("s_waitcnt vmcnt(0)" ::: "memory");
        }
    }
    __syncthreads();
}

__global__ void __launch_bounds__(512) fwd_megakernel(Params p) {
    extern __shared__ __attribute__((aligned(16))) unsigned char lds_raw[];
    cg::grid_group grid = cg::this_grid();
    char* lds = (char*)lds_raw;
    const int tid = threadIdx.x, lane = tid & 63, wid = __builtin_amdgcn_readfirstlane(tid >> 6);
    const int G = gridDim.x;
    unsigned char* ws = p.ws;
    float* out = p.out;
    volatile LAS unsigned* bst = (volatile LAS unsigned*)(LAS unsigned char*)(lds_raw + LDS_BYTES - 64);
    if (tid < 2) bst[tid] = 0u;
    __syncthreads();
    if (gridDim.y == 0x7fffu) grid.sync();
    const XcdBarrier xbar = xcd_barrier_post((unsigned*)(ws + WS_CTL) + 4096, bst);

#ifndef SKIP_P0
    {
        float* scr = (float*)(lds + wid * 16384);
        const int gw = blockIdx.x * 8 + wid, NGW = G * 8;
        constexpr int I_IN = (DM / 64) * (NIN / 32);
        for (int it = gw; it < I_IN; it += NGW) transpose_item(p.in[2], DM, NIN, NIN, (bf16_t*)(ws + WS_WIN), 0, nullptr, scr, it, lane);
        const float* g1 = p.in[1]; bf16_t* XN = (bf16_t*)(ws + WS_XN);
        f32x4 gv[4];
#pragma unroll
        for (int j = 0; j < 4; ++j) gv[j] = ((const f32x4*)g1)[lane + 64 * j];
        {
            f32x4 nv[4];
            if (gw < M) { const f32x4* xr = (const f32x4*)(p.in[0] + (size_t)gw * DM) + lane;
#pragma unroll
                for (int j = 0; j < 4; ++j) nv[j] = xr[64 * j]; }
            for (int mrow = gw; mrow < M; mrow += NGW) {
                f32x4 v[4]; float s = 0.f;
#pragma unroll
                for (int j = 0; j < 4; ++j) v[j] = nv[j];
                if (mrow + NGW < M) { const f32x4* xr = (const f32x4*)(p.in[0] + (size_t)(mrow + NGW) * DM) + lane;
#pragma unroll
                    for (int j = 0; j < 4; ++j) nv[j] = xr[64 * j]; }
#pragma unroll
                for (int j = 0; j < 4; ++j) s += (v[j][0] * v[j][0] + v[j][1] * v[j][1]) + (v[j][2] * v[j][2] + v[j][3] * v[j][3]);
                const float rstd = 1.0f / sqrtf(wave_sum(s) * (1.0f / DM) + RMS_EPS);
                u32x2* o8 = (u32x2*)(XN + (size_t)mrow * DM) + lane;
#pragma unroll
                for (int j = 0; j < 4; ++j) { const f32x4 y = v[j] * rstd * gv[j]; u32x2 w; w.x = cvt_pk_bf16(y[0], y[1]); w.y = cvt_pk_bf16(y[2], y[3]); o8[64 * j] = w; }
            }
        }
        float* rope = (float*)(ws + WS_ROPE);
        for (int e = blockIdx.x * 512 + tid; e < SEQ * 64; e += G * 512) {
            const int t = e >> 6, j = e & 63;
            const float inv_freq = powf(10000.0f, -(float)j / 64.0f);
            const float ang = (float)t * inv_freq; float sn, cs; sincosf(ang, &sn, &cs);
            rope[(size_t)t * 128 + j] = cs; rope[(size_t)t * 128 + 64 + j] = sn;
        }
    }
#endif
    xcd_barrier(xbar);

#ifndef SKIP_P1
    {
        pg8::Gemm g{(const bf16_t*)(ws + WS_XN), (const bf16_t*)(ws + WS_WIN), M, NIN, DM}; pg8::StaticOrder S; S.init(M, NIN, G, (int)blockIdx.x);
        EpiProj E{(bf16_t*)(ws + WS_Q), (bf16_t*)(ws + WS_K), (bf16_t*)(ws + WS_VT), (bf16_t*)(ws + WS_U), (bf16_t*)out, (float*)(ws + WS_KM), (const float*)(ws + WS_ROPE)};
        pg8::gemm_phase<EpiProj, pg8::StaticOrder, true, true>((PG8_LAS unsigned char*)lds_raw, g, S, E);
    }
#endif
    xcd_barrier(xbar);

#ifndef SKIP_GATE
    gating_phase(p, lds, tid);
#endif
#ifndef SKIP_SSMA
    ssm_phase<false>(p, lds, tid, wid, lane);
#endif
    xcd_barrier(xbar);

#ifndef SKIP_P3A
    attn_gather_phase(p, lds, tid, wid, lane);
#endif
    {
        float* scr = (float*)(lds + wid * 16384);
        const int gw = blockIdx.x * 8 + wid, NGW = G * 8;
        constexpr int I_GLU = (SSMW / 64) * (2048 / 32), I_OUT = (DM / 64) * (DM / 32), I_UP = (DM / 64) * (FF / 32), I_DN = (FF / 64) * (DM / 32);
        for (int it = gw; it < I_GLU + I_OUT + I_UP + I_DN; it += NGW) {
            int r = it;
            if (r < I_GLU) { transpose_item(p.in[11], SSMW, 2048, 2048, (bf16_t*)(ws + WS_WGLU), 1, nullptr, scr, r, lane); continue; } r -= I_GLU;
            if (r < I_OUT) { transpose_item(p.in[12], DM, DM, DM, (bf16_t*)(ws + WS_WOUT), 2, nullptr, scr, r, lane); continue; } r -= I_OUT;
            if (r < I_UP) { transpose_item(p.in[14], DM, FF, FF, (bf16_t*)(ws + WS_WUP), 2, p.in[13], scr, r, lane); continue; } r -= I_UP;
            transpose_item(p.in[15], FF, DM, DM, (bf16_t*)(ws + WS_WDN), 2, nullptr, scr, r, lane);
        }
    }
    xcd_barrier(xbar);

    if ((blockIdx.x >> 3) & 1) { ssm_phase<true>(p, lds, tid, wid, lane); attn_merge_phase(p, tid, wid, lane); }
    else { attn_merge_phase(p, tid, wid, lane); ssm_phase<true>(p, lds, tid, wid, lane); }
    xcd_barrier(xbar);

#ifndef SKIP_P4
    {
        pg8::Gemm g{(const bf16_t*)(ws + WS_Y), (const bf16_t*)(ws + WS_WGLU), M, 2048, SSMW}; pg8::StaticOrder S; S.init(M, 2048, G, (int)blockIdx.x);
        EpiGlu E{(const bf16_t*)out, (const bf16_t*)out + (size_t)M * DM, (const bf16_t*)(ws + WS_Q), (bf16_t*)(ws + WS_K)};
        pg8::gemm_phase<EpiGlu, pg8::StaticOrder, true, true>((PG8_LAS unsigned char*)lds_raw, g, S, E);
    }
#endif
    xcd_barrier(xbar);

#ifndef SKIP_P5
    {
        pg8::Gemm g{(const bf16_t*)(ws + WS_K), (const bf16_t*)(ws + WS_WOUT), M, DM, DM}; pg8::StaticOrder S; S.init(M, DM, G, (int)blockIdx.x);
        EpiRes5 E{p.in[0], (bf16_t*)(ws + WS_VT), (float*)(ws + WS_SS)};
        pg8::gemm_phase<EpiRes5, pg8::StaticOrder, true, true>((PG8_LAS unsigned char*)lds_raw, g, S, E);
    }
#endif
    xcd_barrier(xbar);

#ifndef SKIP_P6
    {
        pg8::Gemm g{(const bf16_t*)(ws + WS_VT), (const bf16_t*)(ws + WS_WUP), M, FF, DM}; pg8::StaticOrder S; S.init(M, FF, G, (int)blockIdx.x);
        EpiUp E{(const float*)(ws + WS_SS), (bf16_t*)(ws + WS_H)};
        pg8::gemm_phase<EpiUp, pg8::StaticOrder, true, true>((PG8_LAS unsigned char*)lds_raw, g, S, E);
    }
#endif
    xcd_barrier(xbar);

#ifndef SKIP_P7
    {
        pg8::Gemm g{(const bf16_t*)(ws + WS_H), (const bf16_t*)(ws + WS_WDN), M, DM, FF}; pg8::StaticOrder S; S.init(M, DM, G, (int)blockIdx.x);
        EpiRes7 E{(const bf16_t*)(ws + WS_VT), (bf16_t*)(ws + WS_Q)};
        pg8::gemm_phase<EpiRes7, pg8::StaticOrder, true, true>((PG8_LAS unsigned char*)lds_raw, g, S, E);
    }
#endif
    xcd_barrier(xbar);

    {
        const int gw = blockIdx.x * 8 + wid, NGW = G * 8;
        const bf16_t* X2 = (const bf16_t*)(ws + WS_Q);
        f32x4 gv[4];
#pragma unroll
        for (int j = 0; j < 4; ++j) gv[j] = ((const f32x4*)p.in[16])[4 * lane + j];
        u32x4 n0, n1;
        if (gw < M) { const u32x4* xr = (const u32x4*)(X2 + (size_t)gw * DM) + 2 * lane; n0 = xr[0]; n1 = xr[1]; }
        for (int mrow = gw; mrow < M; mrow += NGW) {
            const u32x4 w0 = n0, w1 = n1;
            if (mrow + NGW < M) { const u32x4* xn = (const u32x4*)(X2 + (size_t)(mrow + NGW) * DM) + 2 * lane; n0 = xn[0]; n1 = xn[1]; }
            f32x4 v[4]; float s = 0.f;
#pragma unroll
            for (int j = 0; j < 2; ++j) { v[j] = (f32x4){__uint_as_float(w0[2 * j] << 16), __uint_as_float(w0[2 * j] & 0xffff0000u), __uint_as_float(w0[2 * j + 1] << 16), __uint_as_float(w0[2 * j + 1] & 0xffff0000u)};
                v[2 + j] = (f32x4){__uint_as_float(w1[2 * j] << 16), __uint_as_float(w1[2 * j] & 0xffff0000u), __uint_as_float(w1[2 * j + 1] << 16), __uint_as_float(w1[2 * j + 1] & 0xffff0000u)}; }
#pragma unroll
            for (int j = 0; j < 4; ++j) s += (v[j][0] * v[j][0] + v[j][1] * v[j][1]) + (v[j][2] * v[j][2] + v[j][3] * v[j][3]);
            const float rstd = 1.0f / sqrtf(wave_sum(s) * (1.0f / DM) + RMS_EPS);
            f32x4* xr = (f32x4*)(out + (size_t)mrow * DM) + 4 * lane;
#pragma unroll
            for (int j = 0; j < 4; ++j) xr[j] = v[j] * rstd * gv[j];
        }
    }
}

extern "C" void kernel_launch(void* const* d_in, const int* in_sizes, int n_in, void* d_out, int out_size, void* d_ws, size_t ws_size, hipStream_t stream) {
    static int grid = 0;
    if (grid == 0) {
        if (n_in != 17 || in_sizes[0] != M * DM || out_size != M * DM || ws_size < WS_END) { fprintf(stderr, "kernel_launch: unexpected shapes / workspace (%zu)\n", ws_size); grid = -1; return; }
        int dev = 0, cus = 0, per_cu = 0;
        hipGetDevice(&dev); hipDeviceGetAttribute(&cus, hipDeviceAttributeMultiprocessorCount, dev);
        hipFuncSetAttribute((const void*)fwd_megakernel, hipFuncAttributeMaxDynamicSharedMemorySize, LDS_BYTES);
        hipOccupancyMaxActiveBlocksPerMultiprocessor(&per_cu, (const void*)fwd_megakernel, 512, LDS_BYTES);
        (void)hipGetLastError();
        if (per_cu < 1) { fprintf(stderr, "kernel_launch: occupancy query says %d blocks/CU\n", per_cu); per_cu = 1; }
        grid = cus;
    }
    if (grid < 0) return;
    hipMemsetAsync((char*)d_ws + WS_CTL, 0, 32768, stream);
    Params p{};
    for (int i = 0; i < 17; ++i) p.in[i] = (const float*)d_in[i];
    p.out = (float*)d_out; p.ws = (unsigned char*)d_ws;
    void* args[] = {&p};
    hipError_t e = hipLaunchCooperativeKernel((const void*)fwd_megakernel, dim3(grid), dim3(512), args, LDS_BYTES, stream);
    if (e != hipSuccess) fprintf(stderr, "cooperative launch failed: %s (grid %d)\n", hipGetErrorString(e), grid);
}
```

```cpp
#include <hip/hip_runtime.h>
#include <hip/hip_cooperative_groups.h>
#include <cstdio>
#include <cstdint>
namespace cg = cooperative_groups;

namespace pg8 {
#define PG8_LAS __attribute__((address_space(3)))
typedef unsigned short bf16_t;
typedef short bf16x8 __attribute__((ext_vector_type(8)));
typedef float f32x4 __attribute__((ext_vector_type(4)));
typedef unsigned u32x4 __attribute__((ext_vector_type(4)));
typedef unsigned u32x2 __attribute__((ext_vector_type(2)));
constexpr int BM = 256, BK = 64, HALF = 128, HTB = HALF * BK * 2, STAGE_BYTES = 8 * HTB, NXCD = 8, WGM = 4;

__host__ __device__ __forceinline__ int lds_byte(int r, int c) { const int st = (r >> 4) * 2 + (c >> 5), rr = r & 15, cc = c & 31, ob = rr * 64 + cc * 2; return st * 1024 + (ob ^ (((ob >> 9) & 1) << 5)); }
__host__ __device__ __forceinline__ void stage_rc(int b, int& R, int& C) { const int st = b / 1024, sb = b % 1024, swz = sb ^ (((sb >> 9) & 1) << 5); R = (st >> 1) * 16 + swz / 64; C = (st & 1) * 32 + (swz % 64) / 2; }
__host__ __device__ __forceinline__ int perm32(int rho) { const int n = rho >> 4, i = rho & 15; return 8 * (i >> 2) + 4 * n + (i & 3); }

struct Unit { int pm, pn; };
struct Gemm { const bf16_t* A; const bf16_t* Bt; int M, N, K; };

struct StaticOrder {
    int nM, nN, nwg, G, c;
    __host__ __device__ void init(int M, int N, int G_, int c_) { nM = M / BM; nN = N / BM; nwg = nM * nN; G = G_; c = c_; }
    __host__ __device__ bool next(int i, Unit& u) const {
        const long L = (long)i * G + c; if (L >= nwg) return false;
        int wgid = (int)L; { const int q = nwg / NXCD, r = nwg % NXCD, xcd = wgid % NXCD, off = wgid / NXCD; wgid = (xcd < r ? xcd * (q + 1) : r * (q + 1) + (xcd - r) * q) + off; }
        const int nig = WGM * nN, gid = wgid / nig, fm = gid * WGM, gsz = (nM - fm) < WGM ? (nM - fm) : WGM;
        u.pm = fm + ((wgid % nig) % gsz); u.pn = (wgid % nig) / gsz; return true;
    }
    __device__ __forceinline__ void a_ready(const Unit&) const {}
    __device__ __forceinline__ void done(const Unit&) const {}
};

typedef float f32x2 __attribute__((ext_vector_type(2)));
typedef __bf16 bf16x2_t __attribute__((ext_vector_type(2)));
__device__ __forceinline__ unsigned cvt_pk_bf16(float lo, float hi) { f32x2 v = {lo, hi}; bf16x2_t b = __builtin_convertvector(v, bf16x2_t); return __builtin_bit_cast(unsigned, b); }

template <class Epi, class Sched, bool ALIGN_EPI = false, bool SP2 = false>
__device__ __forceinline__ void gemm_phase(PG8_LAS unsigned char* lds, const Gemm g, const Sched& S, const Epi& E) {
    int tid = threadIdx.x; asm volatile("" : "+v"(tid));
    const int wid = __builtin_amdgcn_readfirstlane(tid >> 6), lane = tid & 63, wr = wid >> 2, wc = wid & 3, fr = lane & 15, fq = lane >> 4;
    const int K = g.K, nt = K / BK;
    unsigned voffA[2], voffB[2];
#pragma unroll
    for (int i = 0; i < 2; ++i) { int R, C; stage_rc(tid * 16 + i * 8192, R, C); const int Rb = Epi::PERM ? ((R & ~31) + perm32(R & 31)) : R;
        voffA[i] = (unsigned)(R * K + C) * 2u; voffB[i] = (unsigned)(Rb * K + C) * 2u; }
    const size_t kstep = (size_t)(BK * 2);
    const size_t hstep = (size_t)HALF * K * 2;
    const size_t tstep = 2 * hstep;
    const unsigned ldsw = (unsigned)wid * 1024u;
    const int aoff = lds_byte(wr * 64 + fr, fq * 8), boff = lds_byte(wc * 32 + fr, fq * 8);
#define PG8_SA(b, h) (((b) * 2 + (h)) * HTB)
#define PG8_SB(b, h) ((4 + (b) * 2 + (h)) * HTB)
#define PG8_STAGE(bufoff, gbase, voff) do { _Pragma("unroll") for (int _i = 0; _i < 2; ++_i) \
        __builtin_amdgcn_global_load_lds((const unsigned*)((const char*)(gbase) + (voff)[_i]), (PG8_LAS unsigned*)(lds + (bufoff) + ldsw + _i * 8192), 16, 0, 0); } while (0)
#define PG8_LDA(dst, b, h) do { _Pragma("unroll") for (int m = 0; m < 4; ++m) _Pragma("unroll") for (int k = 0; k < 2; ++k) dst[m][k] = *(const PG8_LAS bf16x8*)(lds + PG8_SA(b, h) + aoff + m * 2048 + k * 1024); } while (0)
#define PG8_LDB(dst, b, h) do { _Pragma("unroll") for (int n = 0; n < 2; ++n) _Pragma("unroll") for (int k = 0; k < 2; ++k) dst[n][k] = *(const PG8_LAS bf16x8*)(lds + PG8_SB(b, h) + boff + n * 2048 + k * 1024); } while (0)
#define PG8_MMA(ai, bj, At, Bt) do { __builtin_amdgcn_s_setprio(1); _Pragma("unroll") for (int m = 0; m < 4; ++m) _Pragma("unroll") for (int n = 0; n < 2; ++n) _Pragma("unroll") for (int k = 0; k < 2; ++k) \
        acc[ai][bj][m][n] = __builtin_amdgcn_mfma_f32_16x16x32_bf16(Bt[n][k], At[m][k], acc[ai][bj][m][n], 0, 0, 0); __builtin_amdgcn_s_setprio(0); } while (0)
#define PG8_WAIT_V(n) asm volatile("s_waitcnt vmcnt(" #n ")" ::: "memory")
#define PG8_WAIT_L(n) asm volatile("s_waitcnt lgkmcnt(" #n ")" ::: "memory")
#define PG8_BAR __builtin_amdgcn_s_barrier()
#define PG8_SCHED __builtin_amdgcn_sched_barrier(0)
    Unit cur, nxt; int ui = 0;
    if (!S.next(0, cur)) return;
    f32x4 acc[2][2][4][2];
#pragma unroll
    for (int a = 0; a < 2; ++a)
#pragma unroll
        for (int b = 0; b < 2; ++b)
#pragma unroll
            for (int m = 0; m < 4; ++m)
#pragma unroll
                for (int n = 0; n < 2; ++n) acc[a][b][m][n] = (f32x4){0.f, 0.f, 0.f, 0.f};
    bf16x8 At[4][2], B0[2][2], B1[2][2];
    const char* cA = (const char*)g.A + (size_t)cur.pm * tstep; const char* cB = (const char*)g.Bt + (size_t)cur.pn * tstep;
    S.a_ready(cur);
    if constexpr (SP2) {
        PG8_STAGE(PG8_SB(0, 0), cB, voffB); PG8_STAGE(PG8_SB(0, 1), cB + hstep, voffB); PG8_STAGE(PG8_SA(0, 0), cA, voffA); PG8_STAGE(PG8_SA(0, 1), cA + hstep, voffA);
        if (wr == 1) PG8_BAR;
        PG8_WAIT_V(2); PG8_BAR;
        PG8_STAGE(PG8_SB(1, 0), cB + kstep, voffB); PG8_STAGE(PG8_SA(1, 0), cA + kstep, voffA); PG8_STAGE(PG8_SB(1, 1), cB + hstep + kstep, voffB);
        PG8_WAIT_V(6); PG8_BAR;
    } else {
        PG8_STAGE(PG8_SB(0, 0), cB, voffB); PG8_STAGE(PG8_SA(0, 0), cA, voffA); PG8_STAGE(PG8_SB(0, 1), cB + hstep, voffB); PG8_STAGE(PG8_SA(0, 1), cA + hstep, voffA);
        if (wr == 1) PG8_BAR;
        PG8_WAIT_V(4); PG8_BAR;
        PG8_STAGE(PG8_SB(1, 0), cB + kstep, voffB); PG8_STAGE(PG8_SA(1, 0), cA + kstep, voffA); PG8_STAGE(PG8_SB(1, 1), cB + hstep + kstep, voffB);
        PG8_WAIT_V(6); PG8_BAR;
    }
    for (;;) {
        const bool has_next = S.next(ui + 1, nxt);
        const char* nA = has_next ? (const char*)g.A + (size_t)nxt.pm * tstep : cA; const char* nB = has_next ? (const char*)g.Bt + (size_t)nxt.pn * tstep : cB;
        for (int t = 0; t < nt; t += 2) {
            const bool last = (t == nt - 2);
            const char* a1 = cA + (size_t)(t + 1) * kstep;
            const char* a2 = last ? nA : cA + (size_t)(t + 2) * kstep; const char* b2 = last ? nB : cB + (size_t)(t + 2) * kstep;
            const char* a3 = a2 + kstep; const char* b3 = b2 + kstep;
            if (last && has_next) S.a_ready(nxt);
            if constexpr (SP2) {
            PG8_LDB(B0, 0, 0); PG8_LDB(B1, 0, 1); PG8_SCHED; PG8_LDA(At, 0, 0); PG8_STAGE(PG8_SA(1, 1), a1 + hstep, voffA);
            PG8_WAIT_V(8); PG8_WAIT_L(0); PG8_BAR; PG8_MMA(0, 0, At, B0); PG8_MMA(0, 1, At, B1); PG8_BAR; PG8_SCHED;
            PG8_LDA(At, 0, 1); PG8_STAGE(PG8_SB(0, 0), b2, voffB); PG8_STAGE(PG8_SB(0, 1), b2 + hstep, voffB); PG8_STAGE(PG8_SA(0, 0), a2, voffA);
            PG8_WAIT_V(8); PG8_WAIT_L(0); PG8_BAR; PG8_MMA(1, 0, At, B0); PG8_MMA(1, 1, At, B1); PG8_BAR; PG8_SCHED;
            PG8_LDB(B0, 1, 0); PG8_LDB(B1, 1, 1); PG8_SCHED; PG8_LDA(At, 1, 0); PG8_STAGE(PG8_SA(0, 1), a2 + hstep, voffA);
            PG8_WAIT_V(8); PG8_WAIT_L(0); PG8_BAR; PG8_MMA(0, 0, At, B0); PG8_MMA(0, 1, At, B1); PG8_BAR; PG8_SCHED;
            PG8_LDA(At, 1, 1); PG8_STAGE(PG8_SB(1, 0), b3, voffB); PG8_STAGE(PG8_SB(1, 1), b3 + hstep, voffB); PG8_STAGE(PG8_SA(1, 0), a3, voffA);
            PG8_WAIT_V(8); PG8_WAIT_L(0); PG8_BAR; PG8_MMA(1, 0, At, B0); PG8_MMA(1, 1, At, B1); PG8_BAR; PG8_SCHED;
            } else {
            PG8_LDB(B0, 0, 0); PG8_SCHED; PG8_LDA(At, 0, 0); PG8_STAGE(PG8_SA(1, 1), a1 + hstep, voffA);
            PG8_WAIT_L(8); PG8_BAR; PG8_WAIT_L(0); PG8_MMA(0, 0, At, B0); PG8_BAR; PG8_SCHED;
            PG8_LDB(B1, 0, 1); PG8_STAGE(PG8_SB(0, 0), b2, voffB);
            PG8_BAR; PG8_WAIT_L(0); PG8_MMA(0, 1, At, B1); PG8_BAR;
            PG8_LDA(At, 0, 1); PG8_STAGE(PG8_SA(0, 0), a2, voffA);
            PG8_BAR; PG8_WAIT_L(0); PG8_MMA(1, 0, At, B0); PG8_BAR; PG8_SCHED;
            PG8_STAGE(PG8_SB(0, 1), b2 + hstep, voffB);
            PG8_WAIT_V(6); PG8_BAR; PG8_MMA(1, 1, At, B1); PG8_BAR;
            PG8_LDB(B0, 1, 0); PG8_SCHED; PG8_LDA(At, 1, 0); PG8_STAGE(PG8_SA(0, 1), a2 + hstep, voffA);
            PG8_WAIT_L(8); PG8_BAR; PG8_WAIT_L(0); PG8_MMA(0, 0, At, B0); PG8_BAR; PG8_SCHED;
            PG8_LDB(B1, 1, 1); PG8_STAGE(PG8_SB(1, 0), b3, voffB);
            PG8_BAR; PG8_WAIT_L(0); PG8_MMA(0, 1, At, B1); PG8_BAR;
            PG8_LDA(At, 1, 1); PG8_STAGE(PG8_SA(1, 0), a3, voffA);
            PG8_BAR; PG8_WAIT_L(0); PG8_MMA(1, 0, At, B0); PG8_BAR; PG8_SCHED;
            PG8_STAGE(PG8_SB(1, 1), b3 + hstep, voffB);
            PG8_WAIT_V(6); PG8_BAR; PG8_MMA(1, 1, At, B1); PG8_BAR;
            }
        }
        if constexpr (ALIGN_EPI) { if (wr == 0) PG8_BAR; }
        E(acc, cur, wr, wc, fr, fq); S.done(cur);
        if (!has_next) break;
#pragma unroll
        for (int a = 0; a < 2; ++a)
#pragma unroll
            for (int b = 0; b < 2; ++b)
#pragma unroll
                for (int m = 0; m < 4; ++m)
#pragma unroll
                    for (int n = 0; n < 2; ++n) acc[a][b][m][n] = (f32x4){0.f, 0.f, 0.f, 0.f};
        cur = nxt; cA = nA; cB = nB; ++ui;
        if constexpr (ALIGN_EPI) { if (wr == 1) PG8_BAR; }
    }
    PG8_WAIT_V(0);
    if constexpr (!ALIGN_EPI) { if (wr == 0) PG8_BAR; }
    PG8_BAR;
#undef PG8_SA
#undef PG8_SB
#undef PG8_STAGE
#undef PG8_LDA
#undef PG8_LDB
#undef PG8_MMA
#undef PG8_WAIT_V
#undef PG8_WAIT_L
#undef PG8_BAR
#undef PG8_SCHED
}
}

using pg8::bf16_t; using pg8::bf16x8; using pg8::f32x4; using pg8::u32x4; using pg8::u32x2; using pg8::cvt_pk_bf16; using pg8::Unit;
typedef float f32x16 __attribute__((ext_vector_type(16)));
typedef unsigned long long u64;
typedef float f32x2 __attribute__((ext_vector_type(2)));

constexpr int BATCH = 4, SEQ = 8192, DM = 1024, NH = 8, HD = 128, FF = 4096, M = BATCH * SEQ;
constexpr int SSMW = 512, NG = 32, GC = 16, NS = 64, NIN = 5632, NBLK = 32, BLK = 256;
constexpr float RMS_EPS = 1e-6f;
constexpr float QSCALE = 0.08838834764831845f * 1.4426950408889634f;
constexpr int NSEG = SEQ / 64;

constexpr size_t MiB = 1u << 20;
constexpr size_t WS_CTL = 0;
constexpr size_t WS_WIN = 1 * MiB, WS_WGLU = 12 * MiB, WS_WOUT = 14 * MiB, WS_WUP = 16 * MiB, WS_WDN = 24 * MiB;
constexpr size_t WS_ROPE = 33 * MiB;
constexpr size_t WS_KM = 37 * MiB;
constexpr size_t WS_SEL = 38 * MiB;
constexpr size_t WS_SS = 39 * MiB;
constexpr size_t WS_AGG = 41 * MiB;
constexpr size_t WS_ML = 49 * MiB;
constexpr size_t WS_Q = 64 * MiB;
constexpr size_t WS_K = 128 * MiB;
constexpr size_t WS_VT = 192 * MiB;
constexpr size_t WS_U = 256 * MiB;
constexpr size_t WS_Y = 288 * MiB;
constexpr size_t WS_PO = 320 * MiB;
constexpr size_t WS_XN = 320 * MiB;
constexpr size_t WS_H = 256 * MiB;
constexpr size_t WS_END = 512 * MiB;
constexpr int LDS_BYTES = 155648;

__device__ __forceinline__ float sigmoidf_(float x) { return __builtin_amdgcn_rcpf(1.0f + __builtin_amdgcn_exp2f(-1.4426950408889634f * x)); }
__device__ __forceinline__ float bf2f(unsigned short b) { return __uint_as_float((unsigned)b << 16); }
__device__ __forceinline__ float wave_sum(float v) {
#pragma unroll
    for (int o = 1; o < 64; o <<= 1) v += __shfl_xor(v, o);
    return v;
}
__device__ __forceinline__ int crow(int r, int hi) { return (r & 3) + 8 * (r >> 2) + 4 * hi; }

struct Params {
    const float* in[17]; float* out; unsigned char* ws;
};

struct EpiProj {
    static constexpr bool PERM = true, AFTER_DRAIN = false;
    bf16_t *Q, *K, *VT, *U, *GAB; float* KM; const float* rope;
    __device__ __forceinline__ void operator()(const f32x4 (&acc)[2][2][4][2], const Unit& u, int wr, int wc, int fr, int fq) const {
        const int pn = u.pn; const int rbase = u.pm * 256 + wr * 64 + fr;
#ifndef NO_QK
        if (pn < 8) {
            const bool isq = pn < 4; bf16_t* dst = isq ? Q : K; const int hcol = (pn & 3) * 256;
            f32x4 ks[2][2];
#pragma unroll
            for (int a = 0; a < 2; ++a)
#pragma unroll
                for (int b = 0; b < 2; ++b) ks[a][b] = (f32x4){0.f, 0.f, 0.f, 0.f};
#pragma unroll
            for (int ai = 0; ai < 2; ++ai)
#pragma unroll
                for (int m = 0; m < 4; ++m) {
                    const int row = rbase + ai * 128 + m * 16; const int t = row & (SEQ - 1);
                    const f32x4 cs = *(const f32x4*)(rope + (size_t)t * 128 + 16 * wc + 4 * fq);
                    const f32x4 sn = *(const f32x4*)(rope + (size_t)t * 128 + 64 + 16 * wc + 4 * fq);
#pragma unroll
                    for (int bj = 0; bj < 2; ++bj) {
                        const f32x4 x1 = acc[ai][bj][m][0], x2 = acc[ai][bj][m][1];
                        f32x4 o1 = x1 * cs - x2 * sn, o2 = x2 * cs + x1 * sn;
                        if (isq) { o1 = o1 * QSCALE; o2 = o2 * QSCALE; } else { ks[bj][0] += o1; ks[bj][1] += o2; }
                        u32x4 w; w.x = cvt_pk_bf16(o1[0], o1[1]); w.y = cvt_pk_bf16(o1[2], o1[3]); w.z = cvt_pk_bf16(o2[0], o2[1]); w.w = cvt_pk_bf16(o2[2], o2[3]);
                        *(u32x4*)(dst + (size_t)row * DM + hcol + bj * 128 + wc * 32 + 8 * fq) = w;
                    }
                    asm volatile("" ::: "memory");
                }
            if (!isq) {
#pragma unroll
                for (int bj = 0; bj < 2; ++bj)
#pragma unroll
                    for (int n = 0; n < 2; ++n) {
                        f32x4 v = ks[bj][n];
#pragma unroll
                        for (int o = 1; o < 16; o <<= 1) { v[0] += __shfl_xor(v[0], o); v[1] += __shfl_xor(v[1], o); v[2] += __shfl_xor(v[2], o); v[3] += __shfl_xor(v[3], o); }
                        if (fr == 0) *(f32x4*)(KM + (size_t)(u.pm * 2 + wr) * 1024 + hcol + bj * 128 + wc * 32 + 8 * fq + 4 * n) = v;
                    }
            }
        } else
#endif
#ifndef NO_VT
        if (pn < 12) {
            const int b = u.pm >> 5; const int tb = (u.pm & 31) * 256 + wr * 64;
            const unsigned voff = (unsigned)((8 * fq) * SEQ + fr) * 2u;
#pragma unroll
            for (int bj = 0; bj < 2; ++bj)
#pragma unroll
                for (int n = 0; n < 2; ++n)
#pragma unroll
                    for (int i = 0; i < 4; ++i) {
                        char* sb = (char*)VT + ((size_t)((b * NH + (pn - 8) * 2 + bj) * HD + 32 * wc + 4 * n + i) * SEQ + tb) * 2;
#pragma unroll
                        for (int ai = 0; ai < 2; ++ai)
#pragma unroll
                            for (int m = 0; m < 4; ++m) *(bf16_t*)(sb + voff + (ai * 128 + m * 16) * 2) = (bf16_t)(cvt_pk_bf16(acc[ai][bj][m][n][i], 0.f) & 0xffffu);
                    }
        } else
#endif
        if (pn < 14) {
#pragma unroll
            for (int ai = 0; ai < 2; ++ai)
#pragma unroll
                for (int m = 0; m < 4; ++m) { const int row = rbase + ai * 128 + m * 16;
#pragma unroll
                    for (int bj = 0; bj < 2; ++bj) { const f32x4 v0 = acc[ai][bj][m][0], v1 = acc[ai][bj][m][1];
                        u32x4 w; w.x = cvt_pk_bf16(v0[0], v0[1]); w.y = cvt_pk_bf16(v0[2], v0[3]); w.z = cvt_pk_bf16(v1[0], v1[1]); w.w = cvt_pk_bf16(v1[2], v1[3]);
                        *(u32x4*)(U + (size_t)row * SSMW + (pn - 12) * 256 + bj * 128 + wc * 32 + 8 * fq) = w; } }
        } else {
            bf16_t* G = GAB + (pn >= 18 ? (size_t)M * DM : 0); const int cb = ((pn - 14) & 3) * 256;
#pragma unroll
            for (int ai = 0; ai < 2; ++ai)
#pragma unroll
                for (int m = 0; m < 4; ++m) { const int row = rbase + ai * 128 + m * 16;
#pragma unroll
                    for (int bj = 0; bj < 2; ++bj) { const f32x4 v0 = acc[ai][bj][m][0], v1 = acc[ai][bj][m][1];
                        u32x4 w; w.x = cvt_pk_bf16(sigmoidf_(v0[0]), sigmoidf_(v0[1])); w.y = cvt_pk_bf16(sigmoidf_(v0[2]), sigmoidf_(v0[3])); w.z = cvt_pk_bf16(sigmoidf_(v1[0]), sigmoidf_(v1[1])); w.w = cvt_pk_bf16(sigmoidf_(v1[2]), sigmoidf_(v1[3]));
                        *(u32x4*)(G + (size_t)row * DM + cb + bj * 128 + wc * 32 + 8 * fq) = w; }
                    asm volatile("" ::: "memory"); }
        }
    }
};

struct EpiGlu {
    static constexpr bool PERM = true, AFTER_DRAIN = false;
    const bf16_t *GA, *GB, *OA; bf16_t* MIX;
    __device__ __forceinline__ void operator()(const f32x4 (&acc)[2][2][4][2], const Unit& u, int wr, int wc, int fr, int fq) const {
        const int rbase = u.pm * 256 + wr * 64 + fr; const int cb = u.pn * 128 + wc * 32 + 8 * fq;
#pragma unroll
        for (int ai = 0; ai < 2; ++ai) {
            u32x4 ga[4], gb[4], oa[4];
#pragma unroll
            for (int m = 0; m < 4; ++m) { const size_t off = (size_t)(rbase + ai * 128 + m * 16) * DM + cb; ga[m] = *(const u32x4*)(GA + off); gb[m] = *(const u32x4*)(GB + off); oa[m] = *(const u32x4*)(OA + off); }
#pragma unroll
            for (int m = 0; m < 4; ++m) {
                float r[8];
#pragma unroll
                for (int e = 0; e < 8; ++e) {
                    const unsigned gaw = ga[m][e >> 1], gbw = gb[m][e >> 1], oaw = oa[m][e >> 1];
                    const float fa = (e & 1) ? __uint_as_float(gaw & 0xffff0000u) : __uint_as_float(gaw << 16);
                    const float fb = (e & 1) ? __uint_as_float(gbw & 0xffff0000u) : __uint_as_float(gbw << 16);
                    const float fo = (e & 1) ? __uint_as_float(oaw & 0xffff0000u) : __uint_as_float(oaw << 16);
                    const float val = acc[ai][0][m][e >> 2][e & 3], gt = acc[ai][1][m][e >> 2][e & 3];
                    r[e] = fa * fo + fb * (val * sigmoidf_(gt));
                }
                u32x4 w; w.x = cvt_pk_bf16(r[0], r[1]); w.y = cvt_pk_bf16(r[2], r[3]); w.z = cvt_pk_bf16(r[4], r[5]); w.w = cvt_pk_bf16(r[6], r[7]);
                *(u32x4*)(MIX + (size_t)(rbase + ai * 128 + m * 16) * DM + cb) = w;
            }
        }
    }
};

struct EpiRes5 {
    static constexpr bool PERM = true, AFTER_DRAIN = false;
    const float* base; bf16_t* xb; float* SS;
    __device__ __forceinline__ void operator()(const f32x4 (&acc)[2][2][4][2], const Unit& u, int wr, int wc, int fr, int fq) const {
        const int rbase = u.pm * 256 + wr * 64 + fr; const int cb = u.pn * 256 + wc * 32 + 8 * fq;
#pragma unroll
        for (int ai = 0; ai < 2; ++ai) {
            f32x4 bs[4][2][2];
#pragma unroll
            for (int m = 0; m < 4; ++m)
#pragma unroll
                for (int bj = 0; bj < 2; ++bj) { const float* bp = base + (size_t)(rbase + ai * 128 + m * 16) * DM + cb + bj * 128; bs[m][bj][0] = *(const f32x4*)bp; bs[m][bj][1] = *(const f32x4*)(bp + 4); }
#pragma unroll
            for (int m = 0; m < 4; ++m) { const int row = rbase + ai * 128 + m * 16; float s = 0.f;
#pragma unroll
                for (int bj = 0; bj < 2; ++bj) {
                    const f32x4 v0 = bs[m][bj][0] + acc[ai][bj][m][0], v1 = bs[m][bj][1] + acc[ai][bj][m][1];
                    s += ((v0[0] * v0[0] + v0[1] * v0[1]) + (v0[2] * v0[2] + v0[3] * v0[3])) + ((v1[0] * v1[0] + v1[1] * v1[1]) + (v1[2] * v1[2] + v1[3] * v1[3]));
                    u32x4 w; w.x = cvt_pk_bf16(v0[0], v0[1]); w.y = cvt_pk_bf16(v0[2], v0[3]); w.z = cvt_pk_bf16(v1[0], v1[1]); w.w = cvt_pk_bf16(v1[2], v1[3]); *(u32x4*)(xb + (size_t)row * DM + cb + bj * 128) = w;
                }
                s += __shfl_xor(s, 16); s += __shfl_xor(s, 32); if (fq == 0) SS[(size_t)row * 16 + u.pn * 4 + wc] = s;
            }
        }
    }
};
struct EpiRes7 {
    static constexpr bool PERM = true, AFTER_DRAIN = false;
    const bf16_t* base; bf16_t* xo;
    __device__ __forceinline__ void operator()(const f32x4 (&acc)[2][2][4][2], const Unit& u, int wr, int wc, int fr, int fq) const {
        const int rbase = u.pm * 256 + wr * 64 + fr; const int cb = u.pn * 256 + wc * 32 + 8 * fq;
        u32x4 bw[2][4][2];
#pragma unroll
        for (int ai = 0; ai < 2; ++ai)
#pragma unroll
            for (int m = 0; m < 4; ++m)
#pragma unroll
                for (int bj = 0; bj < 2; ++bj) bw[ai][m][bj] = *(const u32x4*)(base + (size_t)(rbase + ai * 128 + m * 16) * DM + cb + bj * 128);
#pragma unroll
        for (int ai = 0; ai < 2; ++ai)
#pragma unroll
            for (int m = 0; m < 4; ++m)
#pragma unroll
                for (int bj = 0; bj < 2; ++bj) {
                    const u32x4 b4 = bw[ai][m][bj]; const f32x4 a0 = acc[ai][bj][m][0], a1 = acc[ai][bj][m][1];
                    u32x4 w;
                    w.x = cvt_pk_bf16(__uint_as_float(b4.x << 16) + a0[0], __uint_as_float(b4.x & 0xffff0000u) + a0[1]);
                    w.y = cvt_pk_bf16(__uint_as_float(b4.y << 16) + a0[2], __uint_as_float(b4.y & 0xffff0000u) + a0[3]);
                    w.z = cvt_pk_bf16(__uint_as_float(b4.z << 16) + a1[0], __uint_as_float(b4.z & 0xffff0000u) + a1[1]);
                    w.w = cvt_pk_bf16(__uint_as_float(b4.w << 16) + a1[2], __uint_as_float(b4.w & 0xffff0000u) + a1[3]);
                    *(u32x4*)(xo + (size_t)(rbase + ai * 128 + m * 16) * DM + cb + bj * 128) = w;
                }
    }
};

struct EpiUp {
    static constexpr bool PERM = true, AFTER_DRAIN = false;
    const float* SS; bf16_t* H;
    __device__ __forceinline__ void operator()(const f32x4 (&acc)[2][2][4][2], const Unit& u, int wr, int wc, int fr, int fq) const {
        const int rbase = u.pm * 256 + wr * 64 + fr;
        float rstd[2][4];
#pragma unroll
        for (int ai = 0; ai < 2; ++ai)
#pragma unroll
            for (int m = 0; m < 4; ++m) { const f32x4* sp = (const f32x4*)(SS + (size_t)(rbase + ai * 128 + m * 16) * 16); const f32x4 s0 = sp[0], s1 = sp[1], s2 = sp[2], s3 = sp[3];
                const float ssum = ((s0[0] + s0[1]) + (s0[2] + s0[3])) + ((s1[0] + s1[1]) + (s1[2] + s1[3])) + ((s2[0] + s2[1]) + (s2[2] + s2[3])) + ((s3[0] + s3[1]) + (s3[2] + s3[3]));
                rstd[ai][m] = 1.0f / sqrtf(ssum * (1.0f / DM) + RMS_EPS); }
#pragma unroll
        for (int ai = 0; ai < 2; ++ai)
#pragma unroll
            for (int m = 0; m < 4; ++m) { const int row = rbase + ai * 128 + m * 16;
#pragma unroll
                for (int bj = 0; bj < 2; ++bj) { f32x4 v0 = acc[ai][bj][m][0] * rstd[ai][m], v1 = acc[ai][bj][m][1] * rstd[ai][m];
#pragma unroll
                    for (int i = 0; i < 4; ++i) { const float r0 = fmaxf(v0[i], 0.f), r1 = fmaxf(v1[i], 0.f); v0[i] = r0 * r0; v1[i] = r1 * r1; }
                    u32x4 w; w.x = cvt_pk_bf16(v0[0], v0[1]); w.y = cvt_pk_bf16(v0[2], v0[3]); w.z = cvt_pk_bf16(v1[0], v1[1]); w.w = cvt_pk_bf16(v1[2], v1[3]);
                    *(u32x4*)(H + (size_t)row * FF + u.pn * 256 + bj * 128 + wc * 32 + 8 * fq) = w; } }
    }
};

__device__ __forceinline__ int src_col(int kind, int j) {
    if (kind == 0) { if (j < 2048) { const int p = j & 127; return (j & ~127) + 64 * ((p >> 2) & 1) + 16 * (p >> 5) + 4 * ((p >> 3) & 3) + (p & 3); } return j; }
    if (kind == 1) { const int h = j >> 8, r = j & 255; return r < 128 ? h * 128 + r : 1024 + h * 128 + (r - 128); }
    return j;
}
__device__ __forceinline__ void transpose_item(const float* W, int K, int Nsrc, int Ndst, bf16_t* WT, int kind, const float* kscale, float* scr, int item, int lane) {
    const int nblk = Ndst / 32, kb = item / nblk, nb = item % nblk, k0 = 64 * kb, j0 = 32 * nb;
    const int sc = src_col(kind, j0 + (lane & 31));
    float tv[32];
#pragma unroll
    for (int i = 0; i < 32; ++i) { const int kk = 2 * i + (lane >> 5); tv[i] = W[(size_t)(k0 + kk) * Nsrc + sc]; }
#pragma unroll
    for (int i = 0; i < 32; ++i) { const int kk = 2 * i + (lane >> 5); float v = tv[i]; if (kscale) v *= kscale[k0 + kk]; scr[kk * 33 + (lane & 31)] = v; }
    __builtin_amdgcn_s_waitcnt(0); __builtin_amdgcn_wave_barrier();
    const int c = lane & 7;
#pragma unroll
    for (int jj = 0; jj < 4; ++jj) { const int n = (lane >> 3) + 8 * jj; const float* s = scr + (8 * c) * 33 + n;
        u32x4 o; o.x = cvt_pk_bf16(s[0 * 33], s[1 * 33]); o.y = cvt_pk_bf16(s[2 * 33], s[3 * 33]); o.z = cvt_pk_bf16(s[4 * 33], s[5 * 33]); o.w = cvt_pk_bf16(s[6 * 33], s[7 * 33]);
        *(u32x4*)(WT + (size_t)(j0 + n) * K + k0 + 8 * c) = o; }
    __builtin_amdgcn_s_waitcnt(0); __builtin_amdgcn_wave_barrier();
}

constexpr int S2_TB = 0, S2_TC = 4096, S2_TA = 4096 + 8704, S2_DS = S2_TA + 2560, S2_XL = S2_DS + 64, S2_XLW = 32 * 272;
constexpr int NCHUNK = 16, CHUNK = 512;
__device__ __forceinline__ void ssm_tables(const Params& p, int g, char* lds, int tid) {
    bf16_t* TB = (bf16_t*)(lds + S2_TB); float* TA = (float*)(lds + S2_TA); float* DS = (float*)(lds + S2_DS);
    const float step = expf(p.in[5][g]);
    for (int e = tid; e < 128 * 16; e += 512) {
        const int j = e >> 4, ch = e & 15, q = j >> 5, n = (q >> 1) * 32 + (j & 31);
        const float lr = p.in[3][g * 64 + n], li = p.in[4][g * 64 + n];
        const float mag = expf(lr * step); float sn, cs; sincosf(li * step, &sn, &cs);
        const float ar = mag * cs, ai = mag * sn, den = lr * lr + li * li, nr = ar - 1.0f, ni = ai;
        const float cr = (nr * lr + ni * li) / den, ci = (ni * lr - nr * li) / den;
        const float bre = p.in[6][(g * 64 + n) * 16 + ch], bim = p.in[7][(g * 64 + n) * 16 + ch];
        const float v = (q & 1) ? (cr * bim + ci * bre) : (cr * bre - ci * bim);
        TB[e] = (bf16_t)(cvt_pk_bf16(v, 0.f) & 0xffffu);
    }
    for (int e = tid; e < 32 * 128; e += 512) {
        const int c = e >> 7, j = e & 127, n = 32 * (j >> 6) + ((j & 63) >> 1);
        float v = 0.f;
        if (c < 16) v = (j & 1) ? -p.in[9][(g * 16 + c) * 64 + n] : p.in[8][(g * 16 + c) * 64 + n];
        *(bf16_t*)(lds + S2_TC + c * 272 + j * 2) = (bf16_t)(cvt_pk_bf16(v, 0.f) & 0xffffu);
    }
    if (tid < 64) {
        const int n = tid; const float lr = p.in[3][g * 64 + n], li = p.in[4][g * 64 + n];
        const float mag = expf(lr * step); float sn, cs; sincosf(li * step, &sn, &cs);
        const float a1r = mag * cs, a1i = mag * sn;
        const float a2r = a1r * a1r - a1i * a1i, a2i = 2.f * a1r * a1i;
        const float a3r = a2r * a1r - a2i * a1i, a3i = a2r * a1i + a2i * a1r;
        const float a4r = a2r * a2r - a2i * a2i, a4i = 2.f * a2r * a2i;
        float pr = a4r, pi = a4i;
#pragma unroll
        for (int k = 0; k < 7; ++k) { const float tr = pr * pr - pi * pi, ti = 2.f * pr * pi; pr = tr; pi = ti; }
        float* o = TA + n * 10; o[0] = a1r; o[1] = a1i; o[2] = a2r; o[3] = a2i; o[4] = a3r; o[5] = a3i; o[6] = a4r; o[7] = a4i; o[8] = pr; o[9] = pi;
    }
    if (tid < 16) DS[tid] = p.in[10][g * 16 + tid];
}
template <bool FULL>
__device__ __forceinline__ void ssm_chunk(const Params& p, int b, int g, int ck, char* lds, int wid, int lane) {
    const int r32 = lane & 31, hi = lane >> 5;
    const bf16_t* U = (const bf16_t*)(p.ws + WS_U); float* AGG = (float*)(p.ws + WS_AGG); bf16_t* Y = (bf16_t*)(p.ws + WS_Y);
    const float* TA = (const float*)(lds + S2_TA); const float* DS = (const float*)(lds + S2_DS);
    char* XL = lds + S2_XL + wid * S2_XLW;
    bf16x8 tbf[4];
#pragma unroll
    for (int q = 0; q < 4; ++q) tbf[q] = *(const bf16x8*)(lds + S2_TB + ((32 * q + r32) * 16 + 8 * hi) * 2);
    float ar[2][4], ai[2][4], bgr[2], bgi[2];
#pragma unroll
    for (int pr = 0; pr < 2; ++pr) { const float* o = TA + (32 * pr + r32) * 10;
#pragma unroll
        for (int k = 0; k < 4; ++k) { ar[pr][k] = o[2 * k]; ai[pr][k] = o[2 * k + 1]; } bgr[pr] = o[8]; bgi[pr] = o[9]; }
    float cr[2] = {0.f, 0.f}, ci[2] = {0.f, 0.f};
    if (FULL) {
        float sr[2][NCHUNK - 1], si[2][NCHUNK - 1];
#pragma unroll
        for (int c2 = 0; c2 < NCHUNK - 1; ++c2)
#pragma unroll
            for (int pr = 0; pr < 2; ++pr) { const float* ag = AGG + (((size_t)(b * NG + g) * NCHUNK + c2) * 64 + 32 * pr + r32) * 2; const f32x2 v = *(const f32x2*)ag; sr[pr][c2] = v.x; si[pr][c2] = v.y; }
#pragma unroll
        for (int c2 = 0; c2 < NCHUNK - 1; ++c2)
            if (c2 < ck) {
#pragma unroll
                for (int pr = 0; pr < 2; ++pr) { const float nr = bgr[pr] * cr[pr] - bgi[pr] * ci[pr] + sr[pr][c2], ni = bgr[pr] * ci[pr] + bgi[pr] * cr[pr] + si[pr][c2]; cr[pr] = nr; ci[pr] = ni; }
            }
    }
    const int row0 = b * SEQ + ck * CHUNK;
    bf16x8 ubn = *(const bf16x8*)(U + (size_t)(row0 + r32) * SSMW + g * 16 + 8 * hi);
#pragma unroll 1
    for (int tl = 0; tl < CHUNK / 32; ++tl) {
        const int row = row0 + 32 * tl + r32;
        const bf16x8 ub = ubn;
        { const int tn = tl + 1 < CHUNK / 32 ? tl + 1 : tl; ubn = *(const bf16x8*)(U + (size_t)(row0 + 32 * tn + r32) * SSMW + g * 16 + 8 * hi); }
#pragma unroll
        for (int pr = 0; pr < 2; ++pr) {
            const f32x16 xr = __builtin_amdgcn_mfma_f32_32x32x16_bf16(ub, tbf[2 * pr], f32x16{}, 0, 0, 0);
            const f32x16 xi = __builtin_amdgcn_mfma_f32_32x32x16_bf16(ub, tbf[2 * pr + 1], f32x16{}, 0, 0, 0);
#define CMADD(acc, A0, A1, pp) ((acc) + (A0) * (pp) + (A1) * __builtin_shufflevector((pp), (pp), 1, 0))
            f32x2 z[16];
#pragma unroll
            for (int r = 0; r < 16; ++r) z[r] = (f32x2){xr[r], xi[r]};
            const f32x2 a1s = {ar[pr][0], ar[pr][0]}, a1x = {-ai[pr][0], ai[pr][0]}, a4s = {ar[pr][3], ar[pr][3]}, a4x = {-ai[pr][3], ai[pr][3]};
#pragma unroll
            for (int q = 0; q < 4; ++q)
#pragma unroll
                for (int k = 1; k < 4; ++k) { const int r = 4 * q + k; z[r] = CMADD(z[r], a1s, a1x, z[r - 1]); }
            f32x2 C = {cr[pr], ci[pr]}; f32x2 my[4];
#pragma unroll
            for (int q = 0; q < 4; ++q) {
                const auto swr = __builtin_amdgcn_permlane32_swap(__float_as_uint(z[4 * q + 3].x), __float_as_uint(z[4 * q + 3].x), false, false);
                const auto swi = __builtin_amdgcn_permlane32_swap(__float_as_uint(z[4 * q + 3].y), __float_as_uint(z[4 * q + 3].y), false, false);
                const f32x2 e0 = {__uint_as_float(swr[0]), __uint_as_float(swi[0])}, e1 = {__uint_as_float(swr[1]), __uint_as_float(swi[1])};
                const f32x2 c0 = C; C = CMADD(e0, a4s, a4x, C);
                const f32x2 c1 = C; C = CMADD(e1, a4s, a4x, C);
                my[q] = hi ? c1 : c0;
            }
            cr[pr] = C.x; ci[pr] = C.y;
            if (FULL) {
#pragma unroll
                for (int k = 0; k < 4; ++k) { const f32x2 aks = {ar[pr][k], ar[pr][k]}, akx = {-ai[pr][k], ai[pr][k]};
#pragma unroll
                    for (int q = 0; q < 4; ++q) { const int r = 4 * q + k; z[r] = CMADD(z[r], aks, akx, my[q]); } }
#pragma unroll
                for (int r = 0; r < 16; ++r) *(unsigned*)(XL + crow(r, hi) * 272 + 128 * pr + 4 * r32) = cvt_pk_bf16(z[r].x, z[r].y);
            }
#undef CMADD
        }
        if (FULL) {
            f32x16 ya = {};
#pragma unroll
            for (int s2 = 0; s2 < 8; ++s2) {
                const bf16x8 xb = *(const bf16x8*)(XL + r32 * 272 + (16 * s2 + 8 * hi) * 2);
                const bf16x8 tc = *(const bf16x8*)(lds + S2_TC + r32 * 272 + (16 * s2 + 8 * hi) * 2);
                ya = __builtin_amdgcn_mfma_f32_32x32x16_bf16(tc, xb, ya, 0, 0, 0);
            }
#pragma unroll
            for (int h2 = 0; h2 < 2; ++h2) {
                const int c0 = 8 * h2 + 4 * hi;
                u32x2 uw;
                { const u32x4 ud = __builtin_bit_cast(u32x4, ub);
                  const auto s0 = __builtin_amdgcn_permlane32_swap(ud[0], ud[2], false, false); const auto s1 = __builtin_amdgcn_permlane32_swap(ud[1], ud[3], false, false);
                  const unsigned own0 = hi ? ud[2] : ud[0], own1 = hi ? ud[3] : ud[1], oth0 = hi ? s0[0] : s0[1], oth1 = hi ? s1[0] : s1[1];
                  uw.x = (h2 == hi) ? own0 : oth0; uw.y = (h2 == hi) ? own1 : oth1; }
                const float uu[4] = {__uint_as_float(uw.x << 16), __uint_as_float(uw.x & 0xffff0000u), __uint_as_float(uw.y << 16), __uint_as_float(uw.y & 0xffff0000u)};
                float v[4];
#pragma unroll
                for (int k = 0; k < 4; ++k) { const float yy = ya[4 * h2 + k] + DS[c0 + k] * uu[k];
                    v[k] = yy * __builtin_amdgcn_rcpf(1.0f + __builtin_amdgcn_exp2f(-2.3022082f * (yy + 0.044715f * yy * yy * yy))); }
                u32x2 w; w.x = cvt_pk_bf16(v[0], v[1]); w.y = cvt_pk_bf16(v[2], v[3]);
                *(u32x2*)(Y + (size_t)row * SSMW + g * 16 + c0) = w;
            }
        }
    }
    if (!FULL) { if (hi == 0) {
#pragma unroll
        for (int pr = 0; pr < 2; ++pr) { float* ag = AGG + (((size_t)(b * NG + g) * NCHUNK + ck) * 64 + 32 * pr + r32) * 2; ag[0] = cr[pr]; ag[1] = ci[pr]; } } }
}
template <bool FULL>
__device__ __forceinline__ void ssm_phase(const Params& p, char* lds, int tid, int wid, int lane) {
    int tid_o = threadIdx.x; asm volatile("" : "+v"(tid_o)); tid = tid_o; lane = tid_o & 63; wid = __builtin_amdgcn_readfirstlane(tid_o >> 6);
    for (int it = blockIdx.x; it < NG * BATCH * 2; it += gridDim.x) {
        const int g = it >> 3, b = (it >> 1) & 3, h2 = it & 1;
        __syncthreads();
        ssm_tables(p, g, lds, tid);
        __syncthreads();
        ssm_chunk<FULL>(p, b, g, h2 * 8 + wid, lds, wid, lane);
    }
    __syncthreads();
}

__device__ __forceinline__ void gating_phase(const Params& p, char* lds, int tid) {
    { int tid_o = threadIdx.x; asm volatile("" : "+v"(tid_o)); tid = tid_o; }
    float* km = (float*)lds;
    const float* KM = (const float*)(p.ws + WS_KM); const bf16_t* Q = (const bf16_t*)(p.ws + WS_Q); unsigned* SEL = (unsigned*)(p.ws + WS_SEL);
    for (int it = blockIdx.x; it < 32 * 16; it += gridDim.x) {
        const int bh = it >> 4, tc = (it & 15) ^ (((it >> 8) & 1) ? 15 : 0), b = bh >> 3, h = bh & 7;
        __syncthreads();
        for (int e = tid; e < 32 * 128; e += 512) { const int n = e >> 7, d = e & 127;
            km[e] = (KM[(size_t)((b * 32 + n) * 2 + 0) * 1024 + h * 128 + d] + KM[(size_t)((b * 32 + n) * 2 + 1) * 1024 + h * 128 + d]) * (1.0f / 256.0f); }
        __syncthreads();
        const int t = tc * 512 + tid, qb = t >> 8;
        unsigned sel;
        if (qb < 4) { sel = qb == 0 ? 0xffffffu : qb == 1 ? 0xffff00u : qb == 2 ? 0xff0100u : 0x020100u; }
        else {
            float q[128];
            const u32x4* qp = (const u32x4*)(Q + (size_t)(b * SEQ + t) * DM + h * 128);
            float v0 = -INFINITY, v1 = -INFINITY, v2 = -INFINITY; int i0 = 255, i1 = 255, i2 = 255;
            unsigned qw[64];
#pragma unroll
            for (int j = 0; j < 16; ++j) { const u32x4 w = qp[j]; qw[4 * j] = w.x; qw[4 * j + 1] = w.y; qw[4 * j + 2] = w.z; qw[4 * j + 3] = w.w; }
            (void)q;
            for (int n = 0; n < qb; ++n) {
                const f32x4* kp = (const f32x4*)(km + n * 128); float g0 = 0.f, g1 = 0.f;
#pragma unroll
                for (int j = 0; j < 32; ++j) { const f32x4 kv = kp[j];
                    g0 += __uint_as_float(qw[2 * j] << 16) * kv[0] + __uint_as_float(qw[2 * j + 1] << 16) * kv[2];
                    g1 += __uint_as_float(qw[2 * j] & 0xffff0000u) * kv[1] + __uint_as_float(qw[2 * j + 1] & 0xffff0000u) * kv[3]; }
                const float gte = g0 + g1;
                if (gte > v0) { v2 = v1; i2 = i1; v1 = v0; i1 = i0; v0 = gte; i0 = n; }
                else if (gte > v1) { v2 = v1; i2 = i1; v1 = gte; i1 = n; }
                else if (gte > v2) { v2 = gte; i2 = n; }
            }
            sel = (unsigned)i0 | ((unsigned)i1 << 8) | ((unsigned)i2 << 16);
        }
        SEL[(size_t)bh * SEQ + t] = sel;
    }
    __syncthreads();
}

constexpr int KP = 272, VP = 520;
constexpr int ATT_K = 0, ATT_V = 256 * KP, ATT_LIST = ATT_V + 128 * VP, ATT_MISC = ATT_LIST + 16384;
__device__ __forceinline__ void stage_kv(const Params& p, int b, int h, int n, char* lds, int tid) {
    const bf16_t* Kg = (const bf16_t*)(p.ws + WS_K) + (size_t)(b * SEQ + n * BLK) * DM + h * HD;
    const bf16_t* Vg = (const bf16_t*)(p.ws + WS_VT) + (size_t)(b * NH + h) * HD * SEQ + n * BLK;
#ifndef STAGE_OLD
    u32x4 kk[8], vv[8];
#pragma unroll
    for (int i = 0; i < 8; ++i) { const int c = tid + i * 512; kk[i] = *(const u32x4*)(Kg + (size_t)(c >> 4) * DM + (c & 15) * 8); vv[i] = *(const u32x4*)(Vg + (size_t)(c >> 5) * SEQ + (c & 31) * 8); }
#pragma unroll
    for (int i = 0; i < 8; ++i) { const int c = tid + i * 512; *(u32x4*)(lds + ATT_K + (c >> 4) * KP + (c & 15) * 16) = kk[i]; { char* vd = lds + ATT_V + (c >> 5) * VP + (c & 31) * 16; *(u32x2*)vd = (u32x2){vv[i].x, vv[i].y}; *(u32x2*)(vd + 8) = (u32x2){vv[i].z, vv[i].w}; } }
#else
#pragma unroll
    for (int i = 0; i < 8; ++i) { const int c = tid + i * 512, r = c >> 4, cc = c & 15; *(u32x4*)(lds + ATT_K + r * KP + cc * 16) = *(const u32x4*)(Kg + (size_t)r * DM + cc * 8); }
#pragma unroll
    for (int i = 0; i < 8; ++i) { const int c = tid + i * 512, r = c >> 5, cc = c & 31; *(u32x4*)(lds + ATT_V + r * VP + cc * 16) = *(const u32x4*)(Vg + (size_t)r * SEQ + cc * 8); }
#endif
}
template <bool CAUSAL>
__device__ __forceinline__ void attn_tile(const char* lds, const bf16x8 (&qf)[8], int qoff, int nchunks, f32x16 (&o)[4], float& m, float& l, int r32, int hi) {
#pragma unroll 4
    for (int c = 0; c < nchunks; ++c) {
        f32x16 s0 = {}, s1 = {};
        const char* kb = lds + ATT_K + (64 * c + r32) * KP + hi * 128;
        {
            bf16x8 ka[4], kc[4];
#pragma unroll
            for (int ks = 0; ks < 4; ++ks) { ka[ks] = *(const bf16x8*)(kb + ks * 16); kc[ks] = *(const bf16x8*)(kb + 32 * KP + ks * 16); }
            __builtin_amdgcn_sched_barrier(0);
            bf16x8 kd[4], ke[4];
#pragma unroll
            for (int ks = 0; ks < 4; ++ks) { kd[ks] = *(const bf16x8*)(kb + (ks + 4) * 16); ke[ks] = *(const bf16x8*)(kb + 32 * KP + (ks + 4) * 16);
                s0 = __builtin_amdgcn_mfma_f32_32x32x16_bf16(ka[ks], qf[ks], s0, 0, 0, 0);
                s1 = __builtin_amdgcn_mfma_f32_32x32x16_bf16(kc[ks], qf[ks], s1, 0, 0, 0); }
            __builtin_amdgcn_sched_barrier(0);
#pragma unroll
            for (int ks = 0; ks < 4; ++ks) {
                s0 = __builtin_amdgcn_mfma_f32_32x32x16_bf16(kd[ks], qf[ks + 4], s0, 0, 0, 0);
                s1 = __builtin_amdgcn_mfma_f32_32x32x16_bf16(ke[ks], qf[ks + 4], s1, 0, 0, 0); }
        }
        if (CAUSAL && c == nchunks - 1) {
#pragma unroll
            for (int r = 0; r < 16; ++r) { const int key = 64 * c + crow(r, hi); if (key > qoff) s0[r] = -INFINITY; if (key + 32 > qoff) s1[r] = -INFINITY; }
        }
#define MX3(a, b, c) __builtin_fmaxf(__builtin_fmaxf((a), (b)), (c))
        float cm = MX3(s0[0], s0[1], s0[2]), cm2 = MX3(s1[0], s1[1], s1[2]);
#pragma unroll
        for (int r = 3; r < 15; r += 2) { cm = MX3(cm, s0[r], s0[r + 1]); cm2 = MX3(cm2, s1[r], s1[r + 1]); }
        cm = MX3(cm, s0[15], s1[15]); cm = __builtin_fmaxf(cm, cm2);
#undef MX3
        { const auto rr = __builtin_amdgcn_permlane32_swap(__float_as_uint(cm), __float_as_uint(cm), false, false); cm = __builtin_fmaxf(__uint_as_float(rr[0]), __uint_as_float(rr[1])); }
        if (__any(cm > m + 8.0f)) {
            const float mn = (cm > m + 8.0f) ? cm : m;
            const float alpha = __builtin_amdgcn_exp2f(m - mn); m = mn; l *= alpha;
#pragma unroll
            for (int dt = 0; dt < 4; ++dt)
#pragma unroll
                for (int r = 0; r < 16; ++r) o[dt][r] *= alpha;
        }
        float ls = 0.f;
#pragma unroll
        for (int r = 0; r < 16; ++r) { s0[r] = __builtin_amdgcn_exp2f(s0[r] - m); s1[r] = __builtin_amdgcn_exp2f(s1[r] - m); ls += s0[r] + s1[r]; }
        l += ls;
        bf16x8 pb[2][2];
#pragma unroll
        for (int kk = 0; kk < 2; ++kk) {
            u32x4 w0, w1;
#pragma unroll
            for (int j = 0; j < 4; ++j) { w0[j] = cvt_pk_bf16(s0[8 * kk + 2 * j], s0[8 * kk + 2 * j + 1]); w1[j] = cvt_pk_bf16(s1[8 * kk + 2 * j], s1[8 * kk + 2 * j + 1]); }
            pb[0][kk] = __builtin_bit_cast(bf16x8, w0); pb[1][kk] = __builtin_bit_cast(bf16x8, w1);
        }
#pragma unroll
        for (int dp = 0; dp < 2; ++dp) {
            u32x2 vf[2][2][2][2];
#pragma unroll
            for (int d2 = 0; d2 < 2; ++d2) { const char* vb = lds + ATT_V + (32 * (2 * dp + d2) + r32) * VP + (64 * c + 4 * hi) * 2;
#pragma unroll
                for (int hh = 0; hh < 2; ++hh)
#pragma unroll
                    for (int kk = 0; kk < 2; ++kk) { vf[d2][hh][kk][0] = *(const u32x2*)(vb + (32 * hh + 16 * kk) * 2); vf[d2][hh][kk][1] = *(const u32x2*)(vb + (32 * hh + 16 * kk + 8) * 2); } }
            __builtin_amdgcn_sched_barrier(0);
#pragma unroll
            for (int d2 = 0; d2 < 2; ++d2)
#pragma unroll
                for (int hh = 0; hh < 2; ++hh)
#pragma unroll
                    for (int kk = 0; kk < 2; ++kk) {
                        const u32x4 a = {vf[d2][hh][kk][0].x, vf[d2][hh][kk][0].y, vf[d2][hh][kk][1].x, vf[d2][hh][kk][1].y};
                        o[2 * dp + d2] = __builtin_amdgcn_mfma_f32_32x32x16_bf16(__builtin_bit_cast(bf16x8, a), pb[hh][kk], o[2 * dp + d2], 0, 0, 0);
                    }
        }
    }
}
__device__ __forceinline__ void load_q(const Params& p, int row, int h, int hi, bf16x8 (&qf)[8]) {
    const bf16_t* qp = (const bf16_t*)(p.ws + WS_Q) + (size_t)row * DM + h * HD + hi * 64;
#pragma unroll
    for (int ks = 0; ks < 8; ++ks) qf[ks] = *(const bf16x8*)(qp + ks * 8);
}

__device__ __forceinline__ void store_partial(bf16_t* po, const f32x16 (&o)[4], float inv) {
#pragma unroll
    for (int dt = 0; dt < 4; ++dt) {
        u32x4 w0, w1;
#pragma unroll
        for (int j = 0; j < 4; ++j) { w0[j] = cvt_pk_bf16(o[dt][2 * j] * inv, o[dt][2 * j + 1] * inv); w1[j] = cvt_pk_bf16(o[dt][8 + 2 * j] * inv, o[dt][8 + 2 * j + 1] * inv); }
        *(u32x4*)(po + dt * 16) = w0; *(u32x4*)(po + dt * 16 + 8) = w1;
    }
}
__device__ __forceinline__ void attn_gather_phase(const Params& p, char* lds, int tid, int wid, int lane, int cidx = 64) {
    int tid_o = threadIdx.x; asm volatile("" : "+v"(tid_o)); tid = tid_o; lane = tid_o & 63; wid = __builtin_amdgcn_readfirstlane(tid_o >> 6);
    const int r32 = lane & 31, hi = lane >> 5;
    if (wid >= 4) __builtin_amdgcn_s_setprio(1);
    unsigned short* list = (unsigned short*)(lds + ATT_LIST); int* misc = (int*)(lds + ATT_MISC);
    const unsigned* SEL = (const unsigned*)(p.ws + WS_SEL); unsigned* ctl = (unsigned*)(p.ws + WS_CTL);
    bf16_t* PO = (bf16_t*)(p.ws + WS_PO); float* ML = (float*)(p.ws + WS_ML); bf16_t* KB = (bf16_t*)(p.ws + WS_K);
    for (;;) {
        __syncthreads();
        if (tid == 0) { misc[0] = (int)atomicAdd(ctl + cidx, 1u); misc[1] = 0; }
        __syncthreads();
        const int item = misc[0];
        if (item >= 32 * 32) break;
        const int n = item >> 5, bh = item & 31, b = bh >> 3, h = bh & 7;
        stage_kv(p, b, h, n, lds, tid);
#pragma unroll 1
        for (int i0 = 0; i0 < 16; i0 += 4) {
            if (256 * (n + 1) + i0 * 512 >= SEQ) break;
            unsigned sw[4];
#pragma unroll
            for (int i = 0; i < 4; ++i) { const int t = 256 * (n + 1) + tid + (i0 + i) * 512; sw[i] = t < SEQ ? SEL[(size_t)bh * SEQ + t] : 0xffffffffu; }
#pragma unroll
            for (int i = 0; i < 4; ++i) { const int t = 256 * (n + 1) + tid + (i0 + i) * 512; const unsigned w = sw[i];
                const int slot = ((w & 255u) == (unsigned)n) ? 0 : (((w >> 8) & 255u) == (unsigned)n) ? 1 : (((w >> 16) & 255u) == (unsigned)n) ? 2 : -1;
                if (slot >= 0) { const int idx = atomicAdd(&misc[1], 1); list[idx] = (unsigned short)(t | (slot << 13)); } }
        }
        __syncthreads();
        const int cnt = misc[1], ntiles = (cnt + 31) >> 5;
        for (int T = wid; T < ntiles + 8; T += 8) {
            f32x16 o[4]; o[0] = f32x16{}; o[1] = f32x16{}; o[2] = f32x16{}; o[3] = f32x16{};
            float m = -INFINITY, l = 0.f;
            if (T < ntiles) {
                const int ei = T * 32 + r32; const bool valid = ei < cnt;
                const unsigned e = list[valid ? ei : cnt - 1]; const int t = e & 0x1fff, slot = e >> 13; const int row = b * SEQ + t;
                bf16x8 qf[8]; load_q(p, row, h, hi, qf);
                attn_tile<false>(lds, qf, 0, 4, o, m, l, r32, hi);
                l += __shfl_xor(l, 32);
                if (valid) {
                    store_partial(PO + (size_t)slot * M * DM + (size_t)row * DM + h * HD + hi * 64, o, 1.0f / l);
                    if (hi == 0) { float* ml = ML + ((size_t)slot * M * NH + (size_t)row * NH + h) * 2; ml[0] = m; ml[1] = l; }
                }
            } else {
                const int w2 = T - ntiles, qoff = w2 * 32 + r32, row = b * SEQ + n * BLK + qoff;
                bf16x8 qf[8]; load_q(p, row, h, hi, qf);
                attn_tile<true>(lds, qf, qoff, (w2 >> 1) + 1, o, m, l, r32, hi);
                l += __shfl_xor(l, 32);
                store_partial(KB + (size_t)row * DM + h * HD + hi * 64, o, 1.0f / l);
                if (hi == 0) { float* ml = ML + ((size_t)3 * M * NH + (size_t)row * NH + h) * 2; ml[0] = m; ml[1] = l; }
            }
        }
    }
    __builtin_amdgcn_s_setprio(0);
    __syncthreads();
}
__device__ __forceinline__ void attn_merge_phase(const Params& p, int tid, int wid, int lane) {
    int tid_o = threadIdx.x; asm volatile("" : "+v"(tid_o)); tid = tid_o; lane = tid_o & 63; wid = __builtin_amdgcn_readfirstlane(tid_o >> 6);
    const int c = lane & 15, rl = lane >> 4;
    const unsigned* SEL = (const unsigned*)(p.ws + WS_SEL);
    const bf16_t* PO = (const bf16_t*)(p.ws + WS_PO); const bf16_t* KB = (const bf16_t*)(p.ws + WS_K); const float* ML = (const float*)(p.ws + WS_ML); bf16_t* OA = (bf16_t*)(p.ws + WS_Q);
    const int gw = blockIdx.x * 8 + wid, NGW = gridDim.x * 8;
    const int dcol = 32 * ((c >> 1) & 3) + 16 * (c & 1) + 4 * (c >> 3);
#pragma unroll 4
    for (int task = gw; task < (M / 4) * NH; task += NGW) {
        const int h = task & 7, row = (task >> 3) * 4 + rl, b = row >> 13, t = row & (SEQ - 1);
        const size_t rowoff = (size_t)row * DM + h * HD;
        const unsigned sw = SEL[(size_t)(b * NH + h) * SEQ + t];
        u32x4 w[4]; f32x2 ml[4];
#pragma unroll
        for (int j = 0; j < 4; ++j) { ml[j] = *(const f32x2*)(ML + ((size_t)j * M * NH + (size_t)row * NH + h) * 2); w[j] = *(const u32x4*)((j == 3 ? KB : PO + (size_t)j * M * DM) + rowoff + 8 * c); }
        float mx = ml[3].x; float mj[4], lj[4];
#pragma unroll
        for (int j = 0; j < 4; ++j) { const bool v = j == 3 || ((sw >> (8 * j)) & 255u) != 255u; mj[j] = v ? ml[j].x : -INFINITY; lj[j] = v ? ml[j].y : 0.f; mx = fmaxf(mx, mj[j]); }
        float v[8], den = 0.f;
#pragma unroll
        for (int e = 0; e < 8; ++e) v[e] = 0.f;
#pragma unroll
        for (int j = 0; j < 4; ++j) { const float f = __builtin_amdgcn_exp2f(mj[j] - mx) * lj[j]; den += f;
            if (f != 0.f) {
#pragma unroll
                for (int q = 0; q < 4; ++q) { v[2 * q] += f * __uint_as_float(w[j][q] << 16); v[2 * q + 1] += f * __uint_as_float(w[j][q] & 0xffff0000u); } } }
        const float inv = 1.0f / den;
        u32x2 o0, o1; o0.x = cvt_pk_bf16(v[0] * inv, v[1] * inv); o0.y = cvt_pk_bf16(v[2] * inv, v[3] * inv); o1.x = cvt_pk_bf16(v[4] * inv, v[5] * inv); o1.y = cvt_pk_bf16(v[6] * inv, v[7] * inv);
        *(u32x2*)(OA + rowoff + dcol) = o0; *(u32x2*)(OA + rowoff + dcol + 8) = o1;
    }
}

#define LAS __attribute__((address_space(3)))
#define XB_TMO      128
#define XB_XCNT(j)  (256  + 64 * (j))
#define XB_XSUB(j)  (1280 + 64 * (j))
#define XB_XGEN(j)  (2304 + 64 * (j))
#define XB_TOP      3328
#define XB_TOPGEN   3392
#define XCD_BAR_WORDS 3456
#define XB_SPIN_CAP (1u << 18)
__device__ __forceinline__ unsigned xb_ld(unsigned* p)              { return __hip_atomic_load(p, __ATOMIC_RELAXED, __HIP_MEMORY_SCOPE_AGENT); }
__device__ __forceinline__ unsigned xb_add(unsigned* p, unsigned v) { return __hip_atomic_fetch_add(p, v, __ATOMIC_RELAXED, __HIP_MEMORY_SCOPE_AGENT); }
__device__ __forceinline__ unsigned xb_xcc_id() { return (unsigned)__builtin_amdgcn_s_getreg((3 << 11) | 20) & 0xFu; }
#define XB_SPIN(cond, bar) do { unsigned _sp = 0; while (cond) { __builtin_amdgcn_s_sleep(1); \
    if ((++_sp & 255u) == 0u) { if (xb_ld(&(bar)[XB_TMO])) break; if (_sp > XB_SPIN_CAP) { atomicAdd(&(bar)[XB_TMO], 1u); break; } } } } while (0)
struct XcdBarrier { unsigned* bar; unsigned x; volatile LAS unsigned* st; };
__device__ __forceinline__ XcdBarrier xcd_barrier_post(unsigned* bar, volatile LAS unsigned* st) {
    XcdBarrier b; b.bar = bar; b.x = xb_xcc_id(); b.st = st;
    if (threadIdx.x == 0) (void)xb_add(&bar[XB_XCNT(b.x)], 1u);
    return b;
}
__device__ __forceinline__ void xcd_barrier_complete(unsigned* bar, unsigned x, unsigned& nloc, unsigned& nx) {
    const unsigned G = gridDim.x * gridDim.y * gridDim.z;
    unsigned sum, cnt, mine, sp = 0u;
    for (;;) {
        sum = 0u; cnt = 0u; mine = 0u;
#pragma unroll
        for (unsigned j = 0; j < 16; ++j) { const unsigned c = xb_ld(&bar[XB_XCNT(j)]); sum += c; cnt += (c > 0u) ? 1u : 0u; mine = (j == x) ? c : mine; }
        if (sum == G) break;
        __builtin_amdgcn_s_sleep(1);
        if ((++sp & 255u) == 0u) { if (xb_ld(&bar[XB_TMO])) break; if (sp > XB_SPIN_CAP) { atomicAdd(&bar[XB_TMO], 1u); break; } }
    }
    nloc = mine > 0u ? mine : 1u; nx = cnt > 0u ? cnt : 1u;
}
__device__ __forceinline__ void xcd_barrier(const XcdBarrier& b) {
    asm volatile("s_waitcnt vmcnt(0)" ::: "memory");
    __syncthreads();
    if (threadIdx.x == 0) {
        unsigned* bar = b.bar;
        __builtin_amdgcn_s_waitcnt(0);
        unsigned nloc = b.st[0], nx = b.st[1];
        if (nloc == 0u) { xcd_barrier_complete(bar, b.x, nloc, nx); b.st[0] = nloc; b.st[1] = nx; }
        const unsigned old = xb_add(&bar[XB_XSUB(b.x)], 1u);
        const unsigned gen = old / nloc;
        if (old + 1u == (gen + 1u) * nloc) {
            __builtin_amdgcn_fence(__ATOMIC_RELEASE, "agent");
            asm volatile("s_waitcnt vmcnt(0)" ::: "memory");
            const unsigned og = xb_add(&bar[XB_TOP], 1u);
            const unsigned tg = og / nx;
            if (og + 1u == (tg + 1u) * nx) xb_add(&bar[XB_TOPGEN], 1u);
            else XB_SPIN(xb_ld(&bar[XB_TOPGEN]) == tg, bar);
            __builtin_amdgcn_fence(__ATOMIC_ACQUIRE, "agent");
            xb_add(&bar[XB_XGEN(b.x)], 1u);
            asm volatile("s_waitcnt vmcnt(0)" ::: "memory");
        } else {
            XB_SPIN(xb_ld(&bar[XB_XGEN(b.x)]) == gen, bar);
            __builtin_amdgcn_fence(__ATOMIC_ACQUIRE, "agent");
            asm volatile("s_waitcnt vmcnt(0)" ::: "memory");
        }
    }
    __syncthreads();
}

__global__ void __launch_bounds__(512) fwd_megakernel(Params p) {
    extern __shared__ __attribute__((aligned(16))) unsigned char lds_raw[];
    cg::grid_group grid = cg::this_grid();
    char* lds = (char*)lds_raw;
    const int tid = threadIdx.x, lane = tid & 63, wid = __builtin_amdgcn_readfirstlane(tid >> 6);
    const int G = gridDim.x;
    unsigned char* ws = p.ws;
    float* out = p.out;
    volatile LAS unsigned* bst = (volatile LAS unsigned*)(LAS unsigned char*)(lds_raw + LDS_BYTES - 64);
    if (tid < 2) bst[tid] = 0u;
    __syncthreads();
    if (gridDim.y == 0x7fffu) grid.sync();
    const XcdBarrier xbar = xcd_barrier_post((unsigned*)(ws + WS_CTL) + 4096, bst);

#ifndef SKIP_P0
    {
        float* scr = (float*)(lds + wid * 16384);
        const int gw = blockIdx.x * 8 + wid, NGW = G * 8;
        constexpr int I_IN = (DM / 64) * (NIN / 32);
        for (int it = gw; it < I_IN; it += NGW) transpose_item(p.in[2], DM, NIN, NIN, (bf16_t*)(ws + WS_WIN), 0, nullptr, scr, it, lane);
        const float* g1 = p.in[1]; bf16_t* XN = (bf16_t*)(ws + WS_XN);
        f32x4 gv[4];
#pragma unroll
        for (int j = 0; j < 4; ++j) gv[j] = ((const f32x4*)g1)[lane + 64 * j];
        {
            f32x4 nv[4];
            if (gw < M) { const f32x4* xr = (const f32x4*)(p.in[0] + (size_t)gw * DM) + lane;
#pragma unroll
                for (int j = 0; j < 4; ++j) nv[j] = xr[64 * j]; }
            for (int mrow = gw; mrow < M; mrow += NGW) {
                f32x4 v[4]; float s = 0.f;
#pragma unroll
                for (int j = 0; j < 4; ++j) v[j] = nv[j];
                if (mrow + NGW < M) { const f32x4* xr = (const f32x4*)(p.in[0] + (size_t)(mrow + NGW) * DM) + lane;
#pragma unroll
                    for (int j = 0; j < 4; ++j) nv[j] = xr[64 * j]; }
#pragma unroll
                for (int j = 0; j < 4; ++j) s += (v[j][0] * v[j][0] + v[j][1] * v[j][1]) + (v[j][2] * v[j][2] + v[j][3] * v[j][3]);
                const float rstd = 1.0f / sqrtf(wave_sum(s) * (1.0f / DM) + RMS_EPS);
                u32x2* o8 = (u32x2*)(XN + (size_t)mrow * DM) + lane;
#pragma unroll
                for (int j = 0; j < 4; ++j) { const f32x4 y = v[j] * rstd * gv[j]; u32x2 w; w.x = cvt_pk_bf16(y[0], y[1]); w.y = cvt_pk_bf16(y[2], y[3]); o8[64 * j] = w; }
            }
        }
        float* rope = (float*)(ws + WS_ROPE);
        for (int e = blockIdx.x * 512 + tid; e < SEQ * 64; e += G * 512) {
            const int t = e >> 6, j = e & 63;
            const float inv_freq = powf(10000.0f, -(float)j / 64.0f);
            const float ang = (float)t * inv_freq; float sn, cs; sincosf(ang, &sn, &cs);
            rope[(size_t)t * 128 + j] = cs; rope[(size_t)t * 128 + 64 + j] = sn;
        }
    }
#endif
    xcd_barrier(xbar);

#ifndef SKIP_P1
    {
        pg8::Gemm g{(const bf16_t*)(ws + WS_XN), (const bf16_t*)(ws + WS_WIN), M, NIN, DM}; pg8::StaticOrder S; S.init(M, NIN, G, (int)blockIdx.x);
        EpiProj E{(bf16_t*)(ws + WS_Q), (bf16_t*)(ws + WS_K), (bf16_t*)(ws + WS_VT), (bf16_t*)(ws + WS_U), (bf16_t*)out, (float*)(ws + WS_KM), (const float*)(ws + WS_ROPE)};
        pg8::gemm_phase<EpiProj, pg8::StaticOrder, true, true>((PG8_LAS unsigned char*)lds_raw, g, S, E);
    }
#endif
    xcd_barrier(xbar);

#ifndef SKIP_GATE
    gating_phase(p, lds, tid);
#endif
#ifndef SKIP_SSMA
    ssm_phase<false>(p, lds, tid, wid, lane);
#endif
    xcd_barrier(xbar);

#ifndef SKIP_P3A
    attn_gather_phase(p, lds, tid, wid, lane);
#endif
    {
        float* scr = (float*)(lds + wid * 16384);
        const int gw = blockIdx.x * 8 + wid, NGW = G * 8;
        constexpr int I_GLU = (SSMW / 64) * (2048 / 32), I_OUT = (DM / 64) * (DM / 32), I_UP = (DM / 64) * (FF / 32), I_DN = (FF / 64) * (DM / 32);
        for (int it = gw; it < I_GLU + I_OUT + I_UP + I_DN; it += NGW) {
            int r = it;
            if (r < I_GLU) { transpose_item(p.in[11], SSMW, 2048, 2048, (bf16_t*)(ws + WS_WGLU), 1, nullptr, scr, r, lane); continue; } r -= I_GLU;
            if (r < I_OUT) { transpose_item(p.in[12], DM, DM, DM, (bf16_t*)(ws + WS_WOUT), 2, nullptr, scr, r, lane); continue; } r -= I_OUT;
            if (r < I_UP) { transpose_item(p.in[14], DM, FF, FF, (bf16_t*)(ws + WS_WUP), 2, p.in[13], scr, r, lane); continue; } r -= I_UP;
            transpose_item(p.in[15], FF, DM, DM, (bf16_t*)(ws + WS_WDN), 2, nullptr, scr, r, lane);
        }
    }
    xcd_barrier(xbar);

    attn_merge_phase(p, tid, wid, lane); ssm_phase<true>(p, lds, tid, wid, lane);
    xcd_barrier(xbar);

#ifndef SKIP_P4
    {
        pg8::Gemm g{(const bf16_t*)(ws + WS_Y), (const bf16_t*)(ws + WS_WGLU), M, 2048, SSMW}; pg8::StaticOrder S; S.init(M, 2048, G, (int)blockIdx.x);
        EpiGlu E{(const bf16_t*)out, (const bf16_t*)out + (size_t)M * DM, (const bf16_t*)(ws + WS_Q), (bf16_t*)(ws + WS_K)};
        pg8::gemm_phase<EpiGlu, pg8::StaticOrder, true, true>((PG8_LAS unsigned char*)lds_raw, g, S, E);
    }
#endif
    xcd_barrier(xbar);

#ifndef SKIP_P5
    {
        pg8::Gemm g{(const bf16_t*)(ws + WS_K), (const bf16_t*)(ws + WS_WOUT), M, DM, DM}; pg8::StaticOrder S; S.init(M, DM, G, (int)blockIdx.x);
        EpiRes5 E{p.in[0], (bf16_t*)(ws + WS_VT), (float*)(ws + WS_SS)};
        pg8::gemm_phase<EpiRes5, pg8::StaticOrder, true, true>((PG8_LAS unsigned char*)lds_raw, g, S, E);
    }
#endif
    xcd_barrier(xbar);

#ifndef SKIP_P6
    {
        pg8::Gemm g{(const bf16_t*)(ws + WS_VT), (const bf16_t*)(ws + WS_WUP), M, FF, DM}; pg8::StaticOrder S; S.init(M, FF, G, (int)blockIdx.x);
        EpiUp E{(const float*)(ws + WS_SS), (bf16_t*)(ws + WS_H)};
        pg8::gemm_phase<EpiUp, pg8::StaticOrder, true, true>((PG8_LAS unsigned char*)lds_raw, g, S, E);
    }
#endif
    xcd_barrier(xbar);

#ifndef SKIP_P7
    {
        pg8::Gemm g{(const bf16_t*)(ws + WS_H), (const bf16_t*)(ws + WS_WDN), M, DM, FF}; pg8::StaticOrder S; S.init(M, DM, G, (int)blockIdx.x);
        EpiRes7 E{(const bf16_t*)(ws + WS_VT), (bf16_t*)(ws + WS_Q)};
        pg8::gemm_phase<EpiRes7, pg8::StaticOrder, true, true>((PG8_LAS unsigned char*)lds_raw, g, S, E);
    }
#endif
    xcd_barrier(xbar);

    {
        const int gw = blockIdx.x * 8 + wid, NGW = G * 8;
        const bf16_t* X2 = (const bf16_t*)(ws + WS_Q);
        f32x4 gv[4];
#pragma unroll
        for (int j = 0; j < 4; ++j) gv[j] = ((const f32x4*)p.in[16])[4 * lane + j];
        u32x4 n0, n1;
        if (gw < M) { const u32x4* xr = (const u32x4*)(X2 + (size_t)gw * DM) + 2 * lane; n0 = xr[0]; n1 = xr[1]; }
        for (int mrow = gw; mrow < M; mrow += NGW) {
            const u32x4 w0 = n0, w1 = n1;
            if (mrow + NGW < M) { const u32x4* xn = (const u32x4*)(X2 + (size_t)(mrow + NGW) * DM) + 2 * lane; n0 = xn[0]; n1 = xn[1]; }
            f32x4 v[4]; float s = 0.f;
#pragma unroll
            for (int j = 0; j < 2; ++j) { v[j] = (f32x4){__uint_as_float(w0[2 * j] << 16), __uint_as_float(w0[2 * j] & 0xffff0000u), __uint_as_float(w0[2 * j + 1] << 16), __uint_as_float(w0[2 * j + 1] & 0xffff0000u)};
                v[2 + j] = (f32x4){__uint_as_float(w1[2 * j] << 16), __uint_as_float(w1[2 * j] & 0xffff0000u), __uint_as_float(w1[2 * j + 1] << 16), __uint_as_float(w1[2 * j + 1] & 0xffff0000u)}; }
#pragma unroll
            for (int j = 0; j < 4; ++j) s += (v[j][0] * v[j][0] + v[j][1] * v[j][1]) + (v[j][2] * v[j][2] + v[j][3] * v[j][3]);
            const float rstd = 1.0f / sqrtf(wave_sum(s) * (1.0f / DM) + RMS_EPS);
            f32x4* xr = (f32x4*)(out + (size_t)mrow * DM) + 4 * lane;
#pragma unroll
            for (int j = 0; j < 4; ++j) xr[j] = v[j] * rstd * gv[j];
        }
    }
}

extern "C" void kernel_launch(void* const* d_in, const int* in_sizes, int n_in, void* d_out, int out_size, void* d_ws, size_t ws_size, hipStream_t stream) {
    static int grid = 0;
    if (grid == 0) {
        if (n_in != 17 || in_sizes[0] != M * DM || out_size != M * DM || ws_size < WS_END) { fprintf(stderr, "kernel_launch: unexpected shapes / workspace (%zu)\n", ws_size); grid = -1; return; }
        int dev = 0, cus = 0, per_cu = 0;
        hipGetDevice(&dev); hipDeviceGetAttribute(&cus, hipDeviceAttributeMultiprocessorCount, dev);
        hipFuncSetAttribute((const void*)fwd_megakernel, hipFuncAttributeMaxDynamicSharedMemorySize, LDS_BYTES);
        hipOccupancyMaxActiveBlocksPerMultiprocessor(&per_cu, (const void*)fwd_megakernel, 512, LDS_BYTES);
        (void)hipGetLastError();
        if (per_cu < 1) { fprintf(stderr, "kernel_launch: occupancy query says %d blocks/CU\n", per_cu); per_cu = 1; }
        grid = cus;
    }
    if (grid < 0) return;
    hipMemsetAsync((char*)d_ws + WS_CTL, 0, 32768, stream);
    Params p{};
    for (int i = 0; i < 17; ++i) p.in[i] = (const float*)d_in[i];
    p.out = (float*)d_out; p.ws = (unsigned char*)d_ws;
    void* args[] = {&p};
    hipError_t e = hipLaunchCooperativeKernel((const void*)fwd_megakernel, dim3(grid), dim3(512), args, LDS_BYTES, stream);
    if (e != hipSuccess) fprintf(stderr, "cooperative launch failed: %s (grid %d)\n", hipGetErrorString(e), grid);
}
```
